# Optimizing an MI355X kernel written in HIP

```python
import math
import jax
import jax.numpy as jnp
from jax import lax
import numpy as np

D_MODEL = 2048
BATCH = 1
SEQ = 16384
DEPTH = 2
DEC_BATCH = 8
DEC_SEQ = 4096
PAST_LEN = 128

HEAD_DIM = 128
N_HEADS = D_MODEL // HEAD_DIM
H_NA = N_HEADS // 2
H_DIL = N_HEADS - H_NA
W_NA = H_NA * HEAD_DIM
W_DIL = H_DIL * HEAD_DIM
MIX_W = W_NA + W_DIL
GRID_W = 64
NA_ROWS = 8
NA_COLS = 16
DIL_PAIRS = ((128, 1), (512, 4), (2048, 16))
QB = 128
T5_BUCKETS = 32
T5_MAX_DIST = 2048
D_FF = int(math.ceil(8 * D_MODEL / 3 / 256)) * 256
EPS = 1e-6
NEG = -1e30
SCALE = 1.0 / math.sqrt(HEAD_DIM)

kernel_name = 'hymba_natten_longnet_encoder'


def _rmsnorm(x, g):
    xf = x.astype(jnp.float32)
    y = xf * lax.rsqrt(jnp.mean(xf * xf, axis=-1, keepdims=True) + EPS)
    return (y * g.astype(jnp.float32)).astype(x.dtype)


def _t5_bucket(rel):
    half = T5_BUCKETS // 2
    max_exact = half // 2
    n = np.abs(rel)
    large = max_exact + (np.log(np.maximum(n, max_exact) / max_exact)
                         / np.log(T5_MAX_DIST / max_exact) * (half - max_exact)).astype(np.int32)
    large = np.minimum(large, half - 1)
    return (rel > 0).astype(np.int32) * half + np.where(n < max_exact, n, large).astype(np.int32)


def _band_attention(q, k, v, bias, radius):
    N, L, H, Dh = q.shape
    nb = -(-L // QB)
    pad = nb * QB - L
    kw = QB + 2 * radius
    qp = jnp.pad(q, ((0, 0), (0, pad), (0, 0), (0, 0))).reshape(N, nb, QB, H, Dh)
    kp = jnp.pad(k, ((0, 0), (radius, pad + radius), (0, 0), (0, 0)))
    vp = jnp.pad(v, ((0, 0), (radius, pad + radius), (0, 0), (0, 0)))
    idx = np.arange(nb)[:, None] * QB + np.arange(kw)[None, :]
    ks = kp[:, idx]
    vs = vp[:, idx]
    s = jnp.einsum('nbqhd,nbkhd->nbhqk', qp, ks, preferred_element_type=jnp.float32) * SCALE
    off = np.arange(kw)[None, :] - radius - np.arange(QB)[:, None]
    keypos = idx - radius
    valid = (np.abs(off) <= radius)[None] & ((keypos >= 0) & (keypos < L))[:, None, :]
    b = bias[np.clip(off + radius, 0, 2 * radius)].astype(jnp.float32)
    s = jnp.where(valid[None, :, None], s + jnp.transpose(b, (2, 0, 1))[None, None], NEG)
    m = jnp.max(s, axis=-1, keepdims=True)
    p = jnp.exp(s - m)
    l = jnp.sum(p, axis=-1)
    o = jnp.einsum('nbhqk,nbkhd->nbqhd', p, vs.astype(jnp.float32))
    o = o / jnp.transpose(l, (0, 1, 3, 2))[..., None]
    lse = jnp.transpose(m[..., 0] + jnp.log(l), (0, 1, 3, 2))
    o = o.reshape(N, nb * QB, H, Dh)[:, :L]
    lse = lse.reshape(N, nb * QB, H)[:, :L]
    return o, lse


def _dilated_attention(q, k, v, t5_table):
    B, S, H, Dh = q.shape
    outs, lses = [], []
    for window, dil in DIL_PAIRS:
        radius = window // (2 * dil)
        bias = t5_table[_t5_bucket(dil * np.arange(-radius, radius + 1))]
        def split(a):
            return jnp.transpose(a.reshape(B, S // dil, dil, H, Dh), (0, 2, 1, 3, 4)).reshape(B * dil, S // dil, H, Dh)
        o, lse = _band_attention(split(q), split(k), split(v), bias, radius)
        outs.append(jnp.transpose(o.reshape(B, dil, S // dil, H, Dh), (0, 2, 1, 3, 4)).reshape(B, S, H, Dh))
        lses.append(jnp.transpose(lse.reshape(B, dil, S // dil, H), (0, 2, 1, 3)).reshape(B, S, H))
    wts = jax.nn.softmax(jnp.stack(lses, 0), axis=0)
    return jnp.einsum('pbsh,pbshd->bshd', wts, jnp.stack(outs, 0))


def _neighbourhood_attention(q, k, v, rpb):
    B, L, H, Dh = q.shape
    rows = L // GRID_W
    kh = min(NA_ROWS, rows)
    r = np.arange(rows)
    rs = np.clip(r - kh // 2, 0, rows - kh)
    key_rows = rs[:, None] + np.arange(kh)[None, :]
    c = np.arange(GRID_W)
    cs = np.clip(c - NA_COLS // 2, 0, GRID_W - NA_COLS)
    col_ok = (c[None, :] >= cs[:, None]) & (c[None, :] < cs[:, None] + NA_COLS)
    qg = q.reshape(B, rows, GRID_W, H, Dh)
    kg = k.reshape(B, rows, GRID_W, H, Dh)[:, key_rows]
    vg = v.reshape(B, rows, GRID_W, H, Dh)[:, key_rows]
    s = jnp.einsum('brqhd,brikhd->brhqik', qg, kg, preferred_element_type=jnp.float32) * SCALE
    dr_idx = (key_rows - r[:, None]) + NA_ROWS - 1
    dc_idx = np.clip(c[None, :] - c[:, None] + NA_COLS - 1, 0, 2 * NA_COLS - 2)
    bias = rpb[dr_idx[:, None, :, None], dc_idx[None, :, None, :]]
    bias = jnp.transpose(bias, (0, 4, 1, 2, 3)).astype(jnp.float32)
    s = jnp.where(col_ok[:, None, :], s + bias[None], NEG)
    p = jax.nn.softmax(s.reshape(B, rows, H, GRID_W, kh * GRID_W), axis=-1).reshape(s.shape)
    o = jnp.einsum('brhqik,brikhd->brqhd', p, vg.astype(jnp.float32))
    return o.reshape(B, L, H, Dh)


def _layer(x, w_in, w_out, g_attn, g_na, g_dil, rpb, t5_table, g_ffn, w_gate, w_up, w_down):
    B, L, _ = x.shape
    h = _rmsnorm(x, g_attn)
    proj = h @ w_in
    qa, ka, va, qb, kb, vb = jnp.split(
        proj, [W_NA, 2 * W_NA, 3 * W_NA, 3 * W_NA + W_DIL, 3 * W_NA + 2 * W_DIL], axis=-1)
    heads_a = lambda a: a.reshape(B, L, H_NA, HEAD_DIM)
    heads_b = lambda a: a.reshape(B, L, H_DIL, HEAD_DIM)
    oa = _neighbourhood_attention(heads_a(qa), heads_a(ka), heads_a(va), rpb).reshape(B, L, W_NA).astype(x.dtype)
    ob = _dilated_attention(heads_b(qb), heads_b(kb), heads_b(vb), t5_table).reshape(B, L, W_DIL).astype(x.dtype)
    mix = jnp.concatenate([_rmsnorm(oa, g_na), _rmsnorm(ob, g_dil)], axis=-1)
    x = x + mix @ w_out
    h = _rmsnorm(x, g_ffn)
    return x + (jax.nn.silu(h @ w_gate) * (h @ w_up)) @ w_down


def _trunk(x, w_in, w_out, g_attn, g_na, g_dil, rpb_na, t5_table, g_ffn, w_gate, w_up, w_down, g_final):
    for l in range(DEPTH):
        x = _layer(x, w_in[l], w_out[l], g_attn[l], g_na[l], g_dil[l], rpb_na[l], t5_table,
                   g_ffn[l], w_gate[l], w_up[l], w_down[l])
    return _rmsnorm(x, g_final)


def setup_inputs(seed: int = 0) -> dict:
    key = jax.random.key(seed)
    ks = jax.random.split(key, 16)
    f32 = jnp.float32
    def nrm(k, shape, scale):
        return jax.random.normal(k, shape, f32) * scale
    return {
        'x_prompt': nrm(ks[0], (BATCH, SEQ, D_MODEL), 1.0),
        'x_sample': nrm(ks[1], (DEC_BATCH, DEC_SEQ, D_MODEL), 1.0),
        'w_in': nrm(ks[2], (DEPTH, D_MODEL, 3 * MIX_W), D_MODEL ** -0.5),
        'w_out': nrm(ks[3], (DEPTH, MIX_W, D_MODEL), MIX_W ** -0.5),
        'g_attn': 1.0 + nrm(ks[4], (DEPTH, D_MODEL), 0.02),
        'g_na': 1.0 + nrm(ks[5], (DEPTH, W_NA), 0.02),
        'g_dil': 1.0 + nrm(ks[6], (DEPTH, W_DIL), 0.02),
        'rpb_na': nrm(ks[7], (DEPTH, 2 * NA_ROWS - 1, 2 * NA_COLS - 1, H_NA), 0.1),
        't5_table': nrm(ks[8], (T5_BUCKETS, H_DIL), 0.1),
        'g_ffn': 1.0 + nrm(ks[9], (DEPTH, D_MODEL), 0.02),
        'w_gate': nrm(ks[10], (DEPTH, D_MODEL, D_FF), D_MODEL ** -0.5),
        'w_up': nrm(ks[11], (DEPTH, D_MODEL, D_FF), D_MODEL ** -0.5),
        'w_down': nrm(ks[12], (DEPTH, D_FF, D_MODEL), D_FF ** -0.5),
        'g_final': 1.0 + nrm(ks[13], (D_MODEL,), 0.02),
    }


def reference(x_prompt, x_sample, w_in, w_out, g_attn, g_na, g_dil, rpb_na, t5_table, g_ffn, w_gate, w_up, w_down, g_final):
    y_prompt = _trunk(x_prompt, w_in, w_out, g_attn, g_na, g_dil, rpb_na, t5_table, g_ffn, w_gate, w_up, w_down, g_final)
    y_sample = _trunk(x_sample, w_in, w_out, g_attn, g_na, g_dil, rpb_na, t5_table, g_ffn, w_gate, w_up, w_down, g_final)
    return (y_prompt, y_sample)
```

```cpp
#include <hip/hip_runtime.h>
#include <hip/hip_cooperative_groups.h>
#include <cstdio>
#include <cstdint>
namespace cg = cooperative_groups;
__device__ __forceinline__ int ltid() { int t = threadIdx.x; asm volatile("" : "+v"(t)); return t; }
__device__ __forceinline__ int lbid() { int t = blockIdx.x; asm volatile("" : "+s"(t)); return t; }
__device__ __forceinline__ int lgdim() { int t = gridDim.x; asm volatile("" : "+s"(t)); return t; }
namespace pg8 {
#define PG8_LAS __attribute__((address_space(3)))
typedef unsigned short bf16_t;
typedef short bf16x8 __attribute__((ext_vector_type(8)));
typedef float f32x4 __attribute__((ext_vector_type(4)));
typedef unsigned u32x4 __attribute__((ext_vector_type(4)));
constexpr int BM = 256, BK = 64, HALF = 128, HTB = HALF * BK * 2  , STAGE_BYTES = 8 * HTB, NXCD = 8, WGM = 8;

__host__ __device__ __forceinline__ int lds_byte(int r, int c) { const int st = (r >> 4) * 2 + (c >> 5), rr = r & 15, cc = c & 31, ob = rr * 64 + cc * 2; return st * 1024 + (ob ^ (((ob >> 9) & 1) << 5)); }
__host__ __device__ __forceinline__ void stage_rc(int b, int& R, int& C) { const int st = b / 1024, sb = b % 1024, swz = sb ^ (((sb >> 9) & 1) << 5); R = (st >> 1) * 16 + swz / 64; C = (st & 1) * 32 + (swz % 64) / 2; }
__host__ __device__ __forceinline__ int perm32(int rho) { const int n = rho >> 4, i = rho & 15; return 8 * (i >> 2) + 4 * n + (i & 3); }

struct Unit { int pm, pn; };
struct Gemm { const bf16_t* A; const bf16_t* Bt; int M, N, K; };

struct StaticOrder {
    int nM, nN, nwg, G, c;
    __host__ __device__ void init(int M, int N, int G_, int c_) { nM = M / BM; nN = N / BM; nwg = nM * nN; G = G_; c = c_; }
    __host__ __device__ bool next(int i, Unit& u) const {
        const long L = (long)i * G + c; if (L >= nwg) return false;
        int wgid = (int)L; { const int q = nwg / NXCD, r = nwg % NXCD, xcd = wgid % NXCD, off = wgid / NXCD; wgid = (xcd < r ? xcd * (q + 1) : r * (q + 1) + (xcd - r) * q) + off; }
        const int nig = WGM * nN, gid = wgid / nig, fm = gid * WGM, gsz = (nM - fm) < WGM ? (nM - fm) : WGM;
        u.pm = fm + ((wgid % nig) % gsz); u.pn = (wgid % nig) / gsz; return true;
    }
    __device__ __forceinline__ void a_ready(const Unit&) const {}
    __device__ __forceinline__ void done(const Unit&) const {}
};
__device__ __forceinline__ unsigned cvt_pk_bf16(float lo, float hi) { unsigned r; asm volatile("v_cvt_pk_bf16_f32 %0, %1, %2" : "=v"(r) : "v"(lo), "v"(hi)); return r; }
template <class Epi, class Sched, bool STAMP = false>
__device__ __forceinline__ void gemm_phase(PG8_LAS unsigned char* lds, const Gemm g, const Sched& S, const Epi& E, unsigned long long* stamps) {
    const int tid = ltid(), wid = __builtin_amdgcn_readfirstlane(tid >> 6), lane = tid & 63, wr = wid >> 2, wc = wid & 3, fr = lane & 15, fq = lane >> 4;
    const int K = g.K, nt = K / BK;
    int ts_lo = 0, ts_hi = 0, nts = 0; const unsigned long long rt_entry = STAMP ? (unsigned long long)wall_clock64() : 0ull;
#define PG8_STAMP() do { if (STAMP && wid == 0 && nts < 64) { const unsigned long long _c = (unsigned long long)clock64(); \
        ts_lo = (lane == nts) ? (int)(unsigned)_c : ts_lo; ts_hi = (lane == nts) ? (int)(unsigned)(_c >> 32) : ts_hi; ++nts; } } while (0)
    PG8_STAMP();
    unsigned voffA[2], voffB[2];
#pragma unroll
    for (int i = 0; i < 2; ++i) { int R, C; stage_rc(tid * 16 + i * 8192, R, C); const int Rb = Epi::PERM ? ((R & ~31) + perm32(R & 31)) : R;
        voffA[i] = (unsigned)(R * K + C) * 2u; voffB[i] = (unsigned)(Rb * K + C) * 2u; }
    const size_t kstep = (size_t)(BK * 2);
    const size_t hstep = (size_t)HALF * K * 2;
    const size_t tstep = 2 * hstep;
    const unsigned ldsw = (unsigned)wid * 1024u;
    const int aoff = lds_byte(wr * 64 + fr, fq * 8), boff = lds_byte(wc * 32 + fr, fq * 8);
#define PG8_SA(b, h) (((b) * 2 + (h)) * HTB)
#define PG8_SB(b, h) ((4 + (b) * 2 + (h)) * HTB)
#define PG8_STAGE(bufoff, gbase, voff) do { _Pragma("unroll") for (int _i = 0; _i < 2; ++_i) \
        __builtin_amdgcn_global_load_lds((const unsigned*)((const char*)(gbase) + (voff)[_i]), (PG8_LAS unsigned*)(lds + (bufoff) + ldsw + _i * 8192), 16, 0, 0); } while (0)
#define PG8_LDA(dst, b, h) do { _Pragma("unroll") for (int m = 0; m < 4; ++m) _Pragma("unroll") for (int k = 0; k < 2; ++k) dst[m][k] = *(const PG8_LAS bf16x8*)(lds + PG8_SA(b, h) + aoff + m * 2048 + k * 1024); } while (0)
#define PG8_LDB(dst, b, h) do { _Pragma("unroll") for (int n = 0; n < 2; ++n) _Pragma("unroll") for (int k = 0; k < 2; ++k) dst[n][k] = *(const PG8_LAS bf16x8*)(lds + PG8_SB(b, h) + boff + n * 2048 + k * 1024); } while (0)
#define PG8_MMA(ai, bj, At, Bt) do { __builtin_amdgcn_s_setprio(1); _Pragma("unroll") for (int m = 0; m < 4; ++m) _Pragma("unroll") for (int n = 0; n < 2; ++n) _Pragma("unroll") for (int k = 0; k < 2; ++k) \
        acc[ai][bj][m][n] = __builtin_amdgcn_mfma_f32_16x16x32_bf16(Bt[n][k], At[m][k], acc[ai][bj][m][n], 0, 0, 0); __builtin_amdgcn_s_setprio(0); } while (0)
#define PG8_WAIT_V(n) asm volatile("s_waitcnt vmcnt(" #n ")" ::: "memory")
#define PG8_WAIT_L(n) asm volatile("s_waitcnt lgkmcnt(" #n ")" ::: "memory")
#define PG8_BAR __builtin_amdgcn_s_barrier()
#define PG8_SCHED __builtin_amdgcn_sched_barrier(0)
    Unit cur, nxt; int ui = 0;
    if (!S.next(0, cur)) return;
    f32x4 acc[2][2][4][2];
#pragma unroll
    for (int a = 0; a < 2; ++a)
#pragma unroll
        for (int b = 0; b < 2; ++b)
#pragma unroll
            for (int m = 0; m < 4; ++m)
#pragma unroll
                for (int n = 0; n < 2; ++n) acc[a][b][m][n] = (f32x4){0.f, 0.f, 0.f, 0.f};
    bf16x8 At[4][2], B0[2][2], B1[2][2];
    const char* cA = (const char*)g.A + (size_t)cur.pm * tstep; const char* cB = (const char*)g.Bt + (size_t)cur.pn * tstep;
    S.a_ready(cur);
    PG8_STAGE(PG8_SB(0, 0), cB, voffB); PG8_STAGE(PG8_SA(0, 0), cA, voffA); PG8_STAGE(PG8_SB(0, 1), cB + hstep, voffB); PG8_STAGE(PG8_SA(0, 1), cA + hstep, voffA);
    if (wr == 1) PG8_BAR;
    PG8_WAIT_V(4); PG8_BAR;
    PG8_STAGE(PG8_SB(1, 0), cB + kstep, voffB); PG8_STAGE(PG8_SA(1, 0), cA + kstep, voffA); PG8_STAGE(PG8_SB(1, 1), cB + hstep + kstep, voffB);
    PG8_WAIT_V(6); PG8_BAR;
    PG8_STAMP();
    for (;;) {
        const bool has_next = S.next(ui + 1, nxt);
        const char* nA = has_next ? (const char*)g.A + (size_t)nxt.pm * tstep : cA; const char* nB = has_next ? (const char*)g.Bt + (size_t)nxt.pn * tstep : cB;
        for (int t = 0; t < nt; t += 2) {
            const bool last = (t == nt - 2);
            const char* a1 = cA + (size_t)(t + 1) * kstep;
            const char* a2 = last ? nA : cA + (size_t)(t + 2) * kstep; const char* b2 = last ? nB : cB + (size_t)(t + 2) * kstep;
            const char* a3 = a2 + kstep; const char* b3 = b2 + kstep;
            if (last && has_next) S.a_ready(nxt);
            PG8_LDB(B0, 0, 0); PG8_SCHED; PG8_LDA(At, 0, 0); PG8_STAGE(PG8_SA(1, 1), a1 + hstep, voffA);
            PG8_WAIT_L(8); PG8_BAR; PG8_WAIT_L(0); PG8_MMA(0, 0, At, B0); PG8_BAR; PG8_SCHED;
            PG8_LDB(B1, 0, 1); PG8_STAGE(PG8_SB(0, 0), b2, voffB);
            PG8_BAR; PG8_WAIT_L(0); PG8_MMA(0, 1, At, B1); PG8_BAR;
            PG8_LDA(At, 0, 1); PG8_STAGE(PG8_SA(0, 0), a2, voffA);
            PG8_BAR; PG8_WAIT_L(0); PG8_MMA(1, 0, At, B0); PG8_BAR; PG8_SCHED;
            PG8_STAGE(PG8_SB(0, 1), b2 + hstep, voffB);
            PG8_WAIT_V(6); PG8_BAR; PG8_MMA(1, 1, At, B1); PG8_BAR;
            PG8_LDB(B0, 1, 0); PG8_SCHED; PG8_LDA(At, 1, 0); PG8_STAGE(PG8_SA(0, 1), a2 + hstep, voffA);
            PG8_WAIT_L(8); PG8_BAR; PG8_WAIT_L(0); PG8_MMA(0, 0, At, B0); PG8_BAR; PG8_SCHED;
            PG8_LDB(B1, 1, 1); PG8_STAGE(PG8_SB(1, 0), b3, voffB);
            PG8_BAR; PG8_WAIT_L(0); PG8_MMA(0, 1, At, B1); PG8_BAR;
            PG8_LDA(At, 1, 1); PG8_STAGE(PG8_SA(1, 0), a3, voffA);
            PG8_BAR; PG8_WAIT_L(0); PG8_MMA(1, 0, At, B0); PG8_BAR; PG8_SCHED;
            PG8_STAGE(PG8_SB(1, 1), b3 + hstep, voffB);
            PG8_WAIT_V(6); PG8_BAR; PG8_MMA(1, 1, At, B1); PG8_BAR;
        }
        PG8_STAMP();
        if constexpr (!Epi::AFTER_DRAIN) { E(acc, cur, wr, wc, fr, fq); S.done(cur); }
        PG8_STAMP();
        if (!has_next) break;
#pragma unroll
        for (int a = 0; a < 2; ++a)
#pragma unroll
            for (int b = 0; b < 2; ++b)
#pragma unroll
                for (int m = 0; m < 4; ++m)
#pragma unroll
                    for (int n = 0; n < 2; ++n) acc[a][b][m][n] = (f32x4){0.f, 0.f, 0.f, 0.f};
        cur = nxt; cA = nA; cB = nB; ++ui;
    }
    PG8_WAIT_V(0);
    if (wr == 0) PG8_BAR;
    PG8_BAR;
    if constexpr (Epi::AFTER_DRAIN) { E.fused(acc, cur, wr, wc, fr, fq, lds, wid, lane); S.done(cur); }
    PG8_STAMP();
    if (STAMP && wid == 0) { stamps[lane] = lane < nts ? (((unsigned long long)(unsigned)ts_hi << 32) | (unsigned)ts_lo) : 0ull;
        if (lane == 62) stamps[62] = rt_entry; if (lane == 63) stamps[63] = (unsigned long long)wall_clock64(); }
#undef PG8_STAMP
#undef PG8_SA
#undef PG8_SB
#undef PG8_STAGE
#undef PG8_LDA
#undef PG8_LDB
#undef PG8_MMA
#undef PG8_WAIT_V
#undef PG8_WAIT_L
#undef PG8_BAR
#undef PG8_SCHED
}
}
using pg8::bf16_t; using pg8::bf16x8; using pg8::f32x4; using pg8::u32x4;
typedef float f32x16 __attribute__((ext_vector_type(16)));
typedef short s16x4 __attribute__((ext_vector_type(4)));
typedef unsigned u32x2 __attribute__((ext_vector_type(2)));

constexpr int NTOK = 49152, DM = 2048, NQKV = 6144, DFF = 5632, LP = 16384, LS = 4096, DEPTH = 2;
constexpr float EPS = 1e-6f;
constexpr float SCALE = 0.08838834764831845f;
constexpr int LDS_BYTES = pg8::STAGE_BYTES;
constexpr size_t E_WIN = (size_t)NQKV * DM, E_WOUT = (size_t)DM * DM, E_WGU = (size_t)2 * DFF * DM, E_WDN = (size_t)DM * DFF;
constexpr size_t OFF_WIN = 0, OFF_WOUT = OFF_WIN + 2 * E_WIN, OFF_WGU = OFF_WOUT + 2 * E_WOUT, OFF_WDN = OFF_WGU + 2 * E_WGU, OFF_QKV = OFF_WDN + 2 * E_WDN;
constexpr size_t OFF_H = OFF_QKV + (size_t)NTOK * NQKV * 2, OFF_LSE = OFF_H + (size_t)NTOK * DM * 2, WS_END = OFF_LSE + (size_t)NTOK * 8 * 4;

struct Params {
    const float *xp, *xs, *w_in, *w_out, *g_attn, *g_na, *g_dil, *rpb, *t5, *g_ffn, *w_gate, *w_up, *w_down, *g_final;
    float* out; unsigned char* ws;
};

__device__ __forceinline__ unsigned pk2(float lo, float hi) { unsigned r; asm volatile("v_cvt_pk_bf16_f32 %0, %1, %2" : "=v"(r) : "v"(lo), "v"(hi)); return r; }
__device__ __forceinline__ float wave_sum(float v) {
#pragma unroll
    for (int o = 1; o < 64; o <<= 1) v += __shfl_xor(v, o);
    return v;
}
__device__ __forceinline__ const float* xrow(const Params& p, int layer, int row) {
    if (layer) return p.out + (size_t)row * DM;
    return row < LP ? p.xp + (size_t)row * DM : p.xs + (size_t)(row - LP) * DM;
}

__device__ __forceinline__ void transpose_item(const float* W, int K, int N, bf16_t* WT, int k0, int n0, int dst_row0, float* scr, int lane) {
#pragma unroll 8
    for (int i = 0; i < 32; ++i) { const int kk = 2 * i + (lane >> 5); scr[kk * 33 + (lane & 31)] = W[(size_t)(k0 + kk) * N + n0 + (lane & 31)]; }
    asm volatile("s_waitcnt lgkmcnt(0)" ::: "memory");
    const int c = lane & 7;
#pragma unroll
    for (int j = 0; j < 4; ++j) { const int n = (lane >> 3) + 8 * j; const float* s = scr + (8 * c) * 33 + n;
        u32x4 o; o.x = pk2(s[0 * 33], s[1 * 33]); o.y = pk2(s[2 * 33], s[3 * 33]); o.z = pk2(s[4 * 33], s[5 * 33]); o.w = pk2(s[6 * 33], s[7 * 33]);
        *(u32x4*)(WT + (size_t)(dst_row0 + n) * K + k0 + 8 * c) = o; }
    asm volatile("s_waitcnt lgkmcnt(0)" ::: "memory");
}
__device__ __forceinline__ void phase_weights(const Params& p, int layer, char* lds, int gw, int ngw, int wid, int lane) {
    float* scr = (float*)(lds + wid * 8448);
    constexpr int I_IN = 32 * 192, I_OUT = 32 * 64, I_G = 32 * 176, I_D = 88 * 64, NIT = I_IN + I_OUT + 2 * I_G + I_D;
    bf16_t* wt_in = (bf16_t*)(p.ws + OFF_WIN); bf16_t* wt_out = (bf16_t*)(p.ws + OFF_WOUT); bf16_t* wt_gu = (bf16_t*)(p.ws + OFF_WGU); bf16_t* wt_dn = (bf16_t*)(p.ws + OFF_WDN);
    for (int it = gw; it < NIT; it += ngw) {
        int r = it;
        if (r < I_IN) { const int kb = r / 192, nb = r % 192; transpose_item(p.w_in + (size_t)layer * DM * NQKV, DM, NQKV, wt_in, 64 * kb, 32 * nb, 32 * nb, scr, lane); continue; } r -= I_IN;
        if (r < I_OUT) { const int kb = r / 64, nb = r % 64; transpose_item(p.w_out + (size_t)layer * DM * DM, DM, DM, wt_out, 64 * kb, 32 * nb, 32 * nb, scr, lane); continue; } r -= I_OUT;
        if (r < 2 * I_G) { const int up = r >= I_G; if (up) r -= I_G; const int kb = r / 176, nb = r % 176, n0 = 32 * nb;
            transpose_item((up ? p.w_up : p.w_gate) + (size_t)layer * DM * DFF, DM, DFF, wt_gu, 64 * kb, n0, (n0 >> 7) * 256 + (n0 & 127) + (up ? 128 : 0), scr, lane); continue; } r -= 2 * I_G;
        { const int kb = r / 64, nb = r % 64; transpose_item(p.w_down + (size_t)layer * DFF * DM, DFF, DM, wt_dn, 64 * kb, 32 * nb, 32 * nb, scr, lane); }
    }
}
__device__ __forceinline__ void phase_norm(const Params& p, int layer, const float* g, int gw, int ngw, int lane) {
    bf16_t* H = (bf16_t*)(p.ws + OFF_H);
    const f32x4* gr = (const f32x4*)g + lane;
    for (int row = gw; row < NTOK; row += ngw) {
        const f32x4* xr = (const f32x4*)xrow(p, layer, row) + lane;
        f32x4 v[8]; float s = 0.f;
#pragma unroll
        for (int j = 0; j < 8; ++j) { v[j] = xr[64 * j]; s += (v[j].x * v[j].x + v[j].y * v[j].y) + (v[j].z * v[j].z + v[j].w * v[j].w); }
        const float rstd = 1.0f / sqrtf(wave_sum(s) * (1.0f / DM) + EPS);
        u32x2* o = (u32x2*)(H + (size_t)row * DM) + lane;
#pragma unroll
        for (int j = 0; j < 8; ++j) { const f32x4 gg = gr[64 * j]; u32x2 w; w.x = pk2(v[j].x * rstd * gg.x, v[j].y * rstd * gg.y); w.y = pk2(v[j].z * rstd * gg.z, v[j].w * rstd * gg.w); o[64 * j] = w; }
    }
}
__device__ __forceinline__ void phase_final(const Params& p, int gw, int ngw, int lane) {
    const f32x4* gr = (const f32x4*)p.g_final + lane;
    for (int row = gw; row < NTOK; row += ngw) {
        f32x4* xr = (f32x4*)(p.out + (size_t)row * DM) + lane;
        f32x4 v[8]; float s = 0.f;
#pragma unroll
        for (int j = 0; j < 8; ++j) { v[j] = xr[64 * j]; s += (v[j].x * v[j].x + v[j].y * v[j].y) + (v[j].z * v[j].z + v[j].w * v[j].w); }
        const float rstd = 1.0f / sqrtf(wave_sum(s) * (1.0f / DM) + EPS);
#pragma unroll
        for (int j = 0; j < 8; ++j) { const f32x4 gg = gr[64 * j]; xr[64 * j] = v[j] * rstd * gg; }
    }
}
__device__ __forceinline__ float bf_lo(unsigned w) { return __uint_as_float(w << 16); }
__device__ __forceinline__ float bf_hi(unsigned w) { return __uint_as_float(w & 0xffff0000u); }
__device__ __forceinline__ void phase_mixnorm(const Params& p, int layer, int gw, int ngw, int lane) {
    const bf16_t* qkv = (const bf16_t*)(p.ws + OFF_QKV);
    const f32x4* ga = (const f32x4*)(p.g_na + layer * 1024); const f32x4* gd = (const f32x4*)(p.g_dil + layer * 1024);
    for (int row = gw; row < NTOK; row += ngw) {
        const u32x4* ar = (const u32x4*)(qkv + (size_t)row * NQKV) + lane;
        const f32x4* br = (const f32x4*)(p.ws + OFF_H + (size_t)row * 4096) + lane;
        u32x4 a0 = ar[0], a1 = ar[64]; f32x4 bv[4];
#pragma unroll
        for (int j = 0; j < 4; ++j) bv[j] = br[64 * j];
        float av[16];
        av[0] = bf_lo(a0.x); av[1] = bf_hi(a0.x); av[2] = bf_lo(a0.y); av[3] = bf_hi(a0.y); av[4] = bf_lo(a0.z); av[5] = bf_hi(a0.z); av[6] = bf_lo(a0.w); av[7] = bf_hi(a0.w);
        av[8] = bf_lo(a1.x); av[9] = bf_hi(a1.x); av[10] = bf_lo(a1.y); av[11] = bf_hi(a1.y); av[12] = bf_lo(a1.z); av[13] = bf_hi(a1.z); av[14] = bf_lo(a1.w); av[15] = bf_hi(a1.w);
        float sa = 0.f, sb = 0.f;
#pragma unroll
        for (int j = 0; j < 16; ++j) sa += av[j] * av[j];
#pragma unroll
        for (int j = 0; j < 4; ++j) sb += (bv[j].x * bv[j].x + bv[j].y * bv[j].y) + (bv[j].z * bv[j].z + bv[j].w * bv[j].w);
        const float ra = 1.0f / sqrtf(wave_sum(sa) * (1.0f / 1024) + EPS), rb = 1.0f / sqrtf(wave_sum(sb) * (1.0f / 1024) + EPS);
        bf16_t* mrow = (bf16_t*)(p.ws + OFF_H + (size_t)row * 4096);
#pragma unroll
        for (int q = 0; q < 2; ++q) { const f32x4 g0 = ga[2 * lane + 128 * q], g1 = ga[2 * lane + 1 + 128 * q]; const float* a = av + 8 * q; u32x4 w;
            w.x = pk2(a[0] * ra * g0.x, a[1] * ra * g0.y); w.y = pk2(a[2] * ra * g0.z, a[3] * ra * g0.w); w.z = pk2(a[4] * ra * g1.x, a[5] * ra * g1.y); w.w = pk2(a[6] * ra * g1.z, a[7] * ra * g1.w);
            *((u32x4*)mrow + lane + 64 * q) = w; }
#pragma unroll
        for (int j = 0; j < 4; ++j) { const f32x4 gg = gd[lane + 64 * j]; u32x2 w; w.x = pk2(bv[j].x * rb * gg.x, bv[j].y * rb * gg.y); w.y = pk2(bv[j].z * rb * gg.z, bv[j].w * rb * gg.w);
            *((u32x2*)(mrow + 1024) + lane + 64 * j) = w; }
    }
}

struct EpiBf16Plain {
    static constexpr bool PERM = true, AFTER_DRAIN = false;
    bf16_t* O; int ldc;
    __device__ __forceinline__ void operator()(const f32x4 (&acc)[2][2][4][2], const pg8::Unit& u, int wr, int wc, int fr, int fq) const {
        const int row0 = u.pm * 256 + wr * 64 + fr, col0 = u.pn * 256 + wc * 32 + 8 * fq;
#pragma unroll
        for (int ai = 0; ai < 2; ++ai)
#pragma unroll
            for (int m = 0; m < 4; ++m) { bf16_t* rowp = O + (size_t)(row0 + ai * 128 + m * 16) * ldc + col0;
#pragma unroll
                for (int bj = 0; bj < 2; ++bj) { const f32x4 v0 = acc[ai][bj][m][0], v1 = acc[ai][bj][m][1];
                    u32x4 w; w.x = pk2(v0[0], v0[1]); w.y = pk2(v0[2], v0[3]); w.z = pk2(v1[0], v1[1]); w.w = pk2(v1[2], v1[3]);
                    *(u32x4*)(rowp + bj * 128) = w; } }
    }
};
struct EpiResid {
    static constexpr bool PERM = false, AFTER_DRAIN = false;
    const float* base0; const float* base1; float* out;
    __device__ __forceinline__ void operator()(const f32x4 (&acc)[2][2][4][2], const pg8::Unit& u, int wr, int wc, int fr, int fq) const {
        const int row0 = u.pm * 256 + wr * 64 + fr, col0 = u.pn * 256 + wc * 32 + 4 * fq;
        const float* base = u.pm < 64 ? base0 : base1;
#pragma unroll
        for (int ai = 0; ai < 2; ++ai)
#pragma unroll
            for (int m = 0; m < 4; ++m) { const size_t off = (size_t)(row0 + ai * 128 + m * 16) * DM + col0;
#pragma unroll
                for (int bj = 0; bj < 2; ++bj)
#pragma unroll
                    for (int n = 0; n < 2; ++n) { const f32x4 bs = *(const f32x4*)(base + off + bj * 128 + n * 16); *(f32x4*)(out + off + bj * 128 + n * 16) = bs + acc[ai][bj][m][n]; }
                asm volatile("" ::: "memory"); }
    }
};
__device__ __forceinline__ float silu_mul(float g, float u) { return g * u * __builtin_amdgcn_rcpf(1.0f + __builtin_amdgcn_exp2f(-1.4426950408889634f * g)); }
struct EpiSwiGLU {
    static constexpr bool PERM = true, AFTER_DRAIN = false;
    bf16_t* O;
    __device__ __forceinline__ void operator()(const f32x4 (&acc)[2][2][4][2], const pg8::Unit& u, int wr, int wc, int fr, int fq) const {
        const int row0 = u.pm * 256 + wr * 64 + fr, col0 = u.pn * 128 + wc * 32 + 8 * fq;
#pragma unroll
        for (int ai = 0; ai < 2; ++ai)
#pragma unroll
            for (int m = 0; m < 4; ++m) { bf16_t* rowp = O + (size_t)(row0 + ai * 128 + m * 16) * DFF + col0;
                const f32x4 g0 = acc[ai][0][m][0], g1 = acc[ai][0][m][1], u0 = acc[ai][1][m][0], u1 = acc[ai][1][m][1];
                u32x4 w; w.x = pk2(silu_mul(g0[0], u0[0]), silu_mul(g0[1], u0[1])); w.y = pk2(silu_mul(g0[2], u0[2]), silu_mul(g0[3], u0[3]));
                w.z = pk2(silu_mul(g1[0], u1[0]), silu_mul(g1[1], u1[1])); w.w = pk2(silu_mul(g1[2], u1[2]), silu_mul(g1[3], u1[3]));
                *(u32x4*)rowp = w; }
    }
};
#define KSWZ(row, colB) ((row) * 256 + ((colB) ^ (((row) & 7) << 4)))
#define SBAR() __builtin_amdgcn_sched_barrier(0)
__device__ __forceinline__ int crow(int r, int hi) { return (r & 3) + 8 * (r >> 2) + 4 * hi; }
__device__ __forceinline__ void qkt(f32x16& p0, f32x16& p1, const char* Ks, const bf16x8* qr, int r32, int hi) {
    p0 = f32x16{}; p1 = f32x16{};
#pragma unroll
    for (int d0 = 0; d0 < 8; ++d0) { const int cb = (d0 * 16 + hi * 8) * 2;
        const bf16x8 b0 = *reinterpret_cast<const bf16x8*>(Ks + KSWZ(r32, cb));
        const bf16x8 b1 = *reinterpret_cast<const bf16x8*>(Ks + KSWZ(32 + r32, cb));
        p0 = __builtin_amdgcn_mfma_f32_32x32x16_bf16(b0, qr[d0], p0, 0, 0, 0);
        p1 = __builtin_amdgcn_mfma_f32_32x32x16_bf16(b1, qr[d0], p1, 0, 0, 0); }
}
__device__ __forceinline__ int v_st(int k, int c) { const int kk = (k & ~0xC) | ((k & 4) << 1) | ((k & 8) >> 1); return ((kk >> 3) * 4 + (c >> 5)) * 512 + ((kk & 7) * 32 + (c & 31)) * 2; }
__device__ __forceinline__ int v_rd_base(int lane) { return ((lane & 3) << 3) | (((lane >> 2) & 3) << 6) | (((lane >> 4) & 1) << 5) | (((lane >> 5) & 1) << 8); }
constexpr int v_rd_off(int d0, int ks, int half) { return d0 * 512 + ks * 4096 + half * 2048; }
template <int OFF> __device__ __forceinline__ s16x4 tr_read(int vb) {
    s16x4 r; asm volatile("ds_read_b64_tr_b16 %0, %1 offset:%2" : "=&v"(r) : "v"(vb), "i"(OFF) : "memory"); return r;
}
template <int D0> __device__ __forceinline__ void pv_one(f32x16& od, int vb, bf16x8 pa0, bf16x8 pa1, bf16x8 pa2, bf16x8 pa3) {
    const s16x4 l0 = tr_read<v_rd_off(D0, 0, 0)>(vb), h0 = tr_read<v_rd_off(D0, 0, 1)>(vb), l1 = tr_read<v_rd_off(D0, 1, 0)>(vb), h1 = tr_read<v_rd_off(D0, 1, 1)>(vb);
    const s16x4 l2 = tr_read<v_rd_off(D0, 2, 0)>(vb), h2 = tr_read<v_rd_off(D0, 2, 1)>(vb), l3 = tr_read<v_rd_off(D0, 3, 0)>(vb), h3 = tr_read<v_rd_off(D0, 3, 1)>(vb);
    asm volatile("s_waitcnt lgkmcnt(0)" ::: "memory"); SBAR();
#define PK(L, H) (bf16x8){L[0], L[1], L[2], L[3], H[0], H[1], H[2], H[3]}
    od = __builtin_amdgcn_mfma_f32_32x32x16_bf16(pa0, PK(l0, h0), od, 0, 0, 0);
    od = __builtin_amdgcn_mfma_f32_32x32x16_bf16(pa1, PK(l1, h1), od, 0, 0, 0);
    od = __builtin_amdgcn_mfma_f32_32x32x16_bf16(pa2, PK(l2, h2), od, 0, 0, 0);
    od = __builtin_amdgcn_mfma_f32_32x32x16_bf16(pa3, PK(l3, h3), od, 0, 0, 0);
#undef PK
}
__device__ __forceinline__ int t5_bucket(int rel) {
    const int n = rel < 0 ? -rel : rel;
    int b = n;
    if (n >= 8) { b = 5 + (31 - __builtin_clz(n)); if (b > 15) b = 15; }
    return b + (rel > 0 ? 16 : 0);
}

template <bool NA>
__device__ __forceinline__ void attn_item(const Params& p, int layer, int dsel, int item, char* lds) {
    const int tid = ltid(), wid = __builtin_amdgcn_readfirstlane(tid >> 6), lane = tid & 63, r32 = lane & 31, hi = lane >> 5;
    bf16_t* qkv = (bf16_t*)(p.ws + OFF_QKV);
    char* V_lds = lds; char* K_lds = lds + 16384;
    float* wsf = (float*)(lds + 32768) + wid * 64; float* li_l = wsf; float* al_l = wsf + 32;
    float* T = (float*)(lds + 32768 + 2048);
    const float NINF = -__builtin_inff();
    const int h = item & 7, gb = item >> 3;
    int base, L, lb;
    if (gb < 64) { base = 0; L = LP; lb = gb; } else { const int s = (gb - 64) >> 4; lb = (gb - 64) & 15; base = LP + s * LS; L = LS; }
    const int dshift = NA ? 0 : 2 * dsel, d = 1 << dshift;
    const int nbr = (L >> 8) >> dshift;
    const int res = NA ? 0 : lb / nbr, b = NA ? lb : lb % nbr;
    const int q0 = b * 256, Lsub = L >> dshift;
    const int colq = (NA ? 0 : 3072) + h * 128, colk = colq + 1024, colv = colq + 2048;
    const int tok0 = base + res;
    int tlo, thi, kr0 = 0, rq = 0, rsq = 0;
    if (NA) { const int rows = L >> 6, r0 = 4 * lb; kr0 = min(max(r0 - 4, 0), rows - 8); const int kr3 = min(max(r0 + 3 - 4, 0), rows - 8); tlo = 0; thi = kr3 + 8 - kr0;
        rq = r0 + (wid >> 1); rsq = min(max(rq - 4, 0), rows - 8); }
    else { tlo = (q0 == 0) ? 1 : 0; thi = (q0 + 256 == Lsub) ? 5 : 6; }
    __syncthreads();
    if (NA) { for (int i = tid; i < 576; i += 512) { const int idx = i - 48; T[i] = (idx >= 0 && idx < 465) ? p.rpb[((size_t)layer * 465 + idx) * 8 + h] * (1.0f / SCALE) : 0.f; } }
    else { if (tid < 256) { const int j = tid - 128; T[tid] = (j >= -64 && j <= 64) ? p.t5[t5_bucket(d * j) * 8 + h] * (1.0f / SCALE) : NINF; } }
    bf16x8 qr[8];
    { const bf16_t* Qw = qkv + (size_t)(tok0 + (q0 + wid * 32 + r32) * d) * NQKV + colq + hi * 8;
#pragma unroll
      for (int d0 = 0; d0 < 8; ++d0) qr[d0] = *reinterpret_cast<const bf16x8*>(Qw + d0 * 16); }
    const int cq = 32 * (wid & 1) + r32, clo = min(max(cq - 8, 0), 48);
    unsigned vmask = 0;
    if (NA) {
#pragma unroll
        for (int r = 0; r < 16; ++r) { const int ck = crow(r, hi); if ((unsigned)(ck - clo) < 16u) vmask |= 1u << r; if ((unsigned)(ck + 32 - clo) < 16u) vmask |= 1u << (16 + r); } }
    const int sr = tid >> 4, sc = (tid & 15) * 8, vst0 = v_st(sr, sc), vst1 = v_st(32 + sr, sc);
    const int vb0 = (int)(uintptr_t)V_lds + v_rd_base(lane);
    bf16x8 vs0, vs1, ks0, ks1;
#define KT(t) (NA ? (kr0 + (t)) * 64 : q0 - 64 + 64 * (t))
#define SLOAD(t) do { const bf16_t* r0p = qkv + (size_t)(tok0 + (KT(t) + sr) * d) * NQKV + sc; const bf16_t* r1p = r0p + (size_t)32 * d * NQKV; \
    ks0 = *reinterpret_cast<const bf16x8*>(r0p + colk); ks1 = *reinterpret_cast<const bf16x8*>(r1p + colk); \
    vs0 = *reinterpret_cast<const bf16x8*>(r0p + colv); vs1 = *reinterpret_cast<const bf16x8*>(r1p + colv); } while (0)
    float m_reg = -1e30f, l_reg = 0.f; f32x16 o[4] = {};
    constexpr float C = SCALE * 1.4426950408889634f;
    SLOAD(tlo);
    for (int t = tlo; t < thi; ++t) {
        __syncthreads();
        *(bf16x8*)(V_lds + vst0) = vs0; *(bf16x8*)(V_lds + vst1) = vs1;
        *(bf16x8*)(K_lds + KSWZ(sr, sc * 2)) = ks0; *(bf16x8*)(K_lds + KSWZ(32 + sr, sc * 2)) = ks1;
        __syncthreads();
        if (t + 1 < thi) SLOAD(t + 1);
        bool part;
        if (NA) part = (unsigned)(kr0 + t - rsq) < 8u; else part = (unsigned)(t - (wid >> 1)) < 3u;
        if (part) {
            f32x16 p0, p1;
            qkt(p0, p1, K_lds, qr, r32, hi);
            if (NA) { const float* Tb = T + 48 + (kr0 + t - rq + 7) * 31 + 15 - cq + 4 * hi;
#pragma unroll
                for (int r = 0; r < 16; ++r) { const int oo = (r & 3) + 8 * (r >> 2); const float b0 = Tb[oo], b1 = Tb[oo + 32];
                    p0[r] = ((vmask >> r) & 1u) ? p0[r] + b0 : NINF; p1[r] = ((vmask >> (16 + r)) & 1u) ? p1[r] + b1 : NINF; } }
            else { const float* Tb = T + (KT(t) - (q0 + 32 * wid) - r32 + 128 + 4 * hi);
#pragma unroll
                for (int r = 0; r < 16; ++r) { const int oo = (r & 3) + 8 * (r >> 2); p0[r] += Tb[oo]; p1[r] += Tb[oo + 32]; } }
            float pmax = p0[0];
#pragma unroll
            for (int r = 1; r < 16; ++r) pmax = fmaxf(pmax, p0[r]);
#pragma unroll
            for (int r = 0; r < 16; ++r) pmax = fmaxf(pmax, p1[r]);
            { auto rr = __builtin_amdgcn_permlane32_swap(__float_as_uint(pmax), __float_as_uint(pmax), false, false);
              pmax = fmaxf(__uint_as_float(rr[0]), __uint_as_float(rr[1])); }
            const float mn = fmaxf(m_reg, pmax); const float alpha = __builtin_amdgcn_exp2f((m_reg - mn) * C); m_reg = mn;
            const float mnC = -mn * C;
            float ps = 0.f;
#pragma unroll
            for (int r = 0; r < 16; ++r) { p0[r] = __builtin_amdgcn_exp2f(fmaf(p0[r], C, mnC)); p1[r] = __builtin_amdgcn_exp2f(fmaf(p1[r], C, mnC)); ps += p0[r] + p1[r]; }
            { auto rr = __builtin_amdgcn_permlane32_swap(__float_as_uint(ps), __float_as_uint(ps), false, false);
              ps = __uint_as_float(rr[0]) + __uint_as_float(rr[1]); }
            l_reg = l_reg * alpha + ps;
            bf16x8 pa0, pa1, pa2, pa3;
#define PK4(P, BASE, OUT) do { unsigned a0 = pk2(P[BASE + 0], P[BASE + 1]), a1 = pk2(P[BASE + 2], P[BASE + 3]);   \
    unsigned b0 = pk2(P[BASE + 4], P[BASE + 5]), b1 = pk2(P[BASE + 6], P[BASE + 7]);                              \
    auto r0 = __builtin_amdgcn_permlane32_swap(a0, b0, false, false); auto r1 = __builtin_amdgcn_permlane32_swap(a1, b1, false, false); \
    u32x4 w = {r0[0], r1[0], r0[1], r1[1]}; OUT = *reinterpret_cast<bf16x8*>(&w); } while (0)
            PK4(p0, 0, pa0); PK4(p0, 8, pa1); PK4(p1, 0, pa2); PK4(p1, 8, pa3);
#undef PK4
            if (__any(alpha < 1.f)) { if (hi == 0) al_l[r32] = alpha; asm volatile("s_waitcnt lgkmcnt(0)" ::: "memory");
#pragma unroll
                for (int r = 0; r < 16; ++r) { const float a = al_l[crow(r, hi)];
#pragma unroll
                    for (int dd = 0; dd < 4; ++dd) o[dd][r] *= a; } }
            pv_one<0>(o[0], vb0, pa0, pa1, pa2, pa3); pv_one<1>(o[1], vb0, pa0, pa1, pa2, pa3); pv_one<2>(o[2], vb0, pa0, pa1, pa2, pa3); pv_one<3>(o[3], vb0, pa0, pa1, pa2, pa3);
        }
    }
#undef SLOAD
#undef KT
    if (NA) {
        if (hi == 0) li_l[r32] = l_reg; asm volatile("s_waitcnt lgkmcnt(0)" ::: "memory");
        bf16_t* Ow = qkv + (size_t)(tok0 + q0 + wid * 32) * NQKV + colq + r32;
#pragma unroll
        for (int r = 0; r < 16; ++r) { const int orow = crow(r, hi); const float rl = __builtin_amdgcn_rcpf(li_l[orow]);
#pragma unroll
            for (int dd = 0; dd < 4; ++dd) { const unsigned w = pk2(o[dd][r] * rl, 0.f); Ow[(size_t)orow * NQKV + dd * 32] = (bf16_t)(w & 0xffffu); } }
    } else {
        float* lse = (float*)(p.ws + OFF_LSE); float* Hf = (float*)(p.ws + OFF_H);
        const int tq = tok0 + (q0 + wid * 32 + r32) * d;
        const float lse_new = m_reg * SCALE + __logf(l_reg);
        float w_old = 0.f, w_new = 1.0f / l_reg, tot = lse_new;
        if (dsel > 0) { const float lo_ = lse[(size_t)tq * 8 + h]; const float mx = fmaxf(lo_, lse_new); tot = mx + __logf(__expf(lo_ - mx) + __expf(lse_new - mx));
            w_old = __expf(lo_ - tot); w_new = __expf(lse_new - tot) / l_reg; }
        if (hi == 0) { li_l[r32] = w_old; al_l[r32] = w_new; if (dsel < 2) lse[(size_t)tq * 8 + h] = tot; }
        asm volatile("s_waitcnt lgkmcnt(0)" ::: "memory");
#pragma unroll
        for (int r = 0; r < 16; ++r) { const int orow = crow(r, hi); const float fo = li_l[orow], fn = al_l[orow];
            float* op = Hf + (size_t)(tok0 + (q0 + wid * 32 + orow) * d) * 1024 + h * 128 + r32;
#pragma unroll
            for (int dd = 0; dd < 4; ++dd) { float v = o[dd][r] * fn; if (dsel > 0) v += op[dd * 32] * fo; op[dd * 32] = v; } }
    }
}
template <class Epi>
__device__ __forceinline__ void run_gemm(char* lds, const bf16_t* A, const bf16_t* Bt, int N, int K, const Epi& E) {
    pg8::Gemm g; g.A = A; g.Bt = Bt; g.M = NTOK; g.N = N; g.K = K;
    pg8::StaticOrder S; S.init(NTOK, N, lgdim(), lbid());
    pg8::gemm_phase<Epi, pg8::StaticOrder, false>((PG8_LAS unsigned char*)lds, g, S, E, nullptr);
}

template <class T> __device__ __forceinline__ T* launder(T* x) { asm volatile("" : "+s"(x)); return x; }
__device__ __forceinline__ void run_phase(const Params& p0, int layer, int ph, char* shm) {
    Params p = p0;
    p.ws = launder(p.ws); p.out = launder(p.out);
    const int tid = ltid(), wid = __builtin_amdgcn_readfirstlane(tid >> 6), lane = tid & 63;
    const int G = lgdim(), bid = lbid(), gw = bid * 8 + wid, ngw = G * 8;
    bf16_t* qkv = (bf16_t*)(p.ws + OFF_QKV); bf16_t* Hb = (bf16_t*)(p.ws + OFF_H);
    switch (ph) {
    case 0: phase_weights(p, layer, shm, gw, ngw, wid, lane); phase_norm(p, layer, p.g_attn + layer * DM, gw, ngw, lane); break;
    case 1: { EpiBf16Plain E; E.O = qkv; E.ldc = NQKV; run_gemm(shm, Hb, (bf16_t*)(p.ws + OFF_WIN), NQKV, DM, E); } break;
    case 2: for (int it = bid; it < 1536; it += G) attn_item<true>(p, layer, 0, it, shm); break;
    case 3: case 4: case 5: for (int it = bid; it < 1536; it += G) attn_item<false>(p, layer, ph - 3, it, shm); break;
    case 6: phase_mixnorm(p, layer, gw, ngw, lane); break;
    case 7: { EpiResid E; E.base0 = layer ? p.out : p.xp; E.base1 = layer ? p.out : p.xs - (size_t)LP * DM; E.out = p.out; run_gemm(shm, Hb, (bf16_t*)(p.ws + OFF_WOUT), DM, DM, E); } break;
    case 8: phase_norm(p, 1, p.g_ffn + layer * DM, gw, ngw, lane); break;
    case 9: { EpiSwiGLU E; E.O = qkv; run_gemm(shm, Hb, (bf16_t*)(p.ws + OFF_WGU), 2 * DFF, DM, E); } break;
    case 10: { EpiResid E; E.base0 = p.out; E.base1 = p.out; E.out = p.out; run_gemm(shm, qkv, (bf16_t*)(p.ws + OFF_WDN), DM, DFF, E); } break;
    default: phase_final(p, gw, ngw, lane); break;
    }
}
__global__ void __launch_bounds__(512) fwd_megakernel(Params p) {
    extern __shared__ __attribute__((aligned(16))) char shm[];
    cg::grid_group grid = cg::this_grid();
    for (int step = 0; step < 2 * 11 + 1; ++step) {
        const int layer = step / 11, ph = step == 22 ? 11 : step % 11;
        run_phase(p, layer, ph, shm);
        if (ph != 2 && ph != 11) grid.sync();
    }
}

extern "C" void kernel_launch(void* const* d_in, const int* in_sizes, int n_in, void* d_out, int out_size, void* d_ws, size_t ws_size, hipStream_t stream) {
    static int grid = 0;
    if (grid == 0) {
        if (n_in != 14 || ws_size < WS_END) { fprintf(stderr, "kernel_launch: need 14 inputs and %zu bytes of workspace, got %d / %zu\n", (size_t)WS_END, n_in, ws_size); grid = -1; return; }
        int dev = 0, cus = 0, per_cu = 0;
        if (hipGetDevice(&dev) != hipSuccess || hipDeviceGetAttribute(&cus, hipDeviceAttributeMultiprocessorCount, dev) != hipSuccess) { grid = -1; return; }
        if (hipFuncSetAttribute((const void*)fwd_megakernel, hipFuncAttributeMaxDynamicSharedMemorySize, LDS_BYTES) != hipSuccess) { fprintf(stderr, "kernel_launch: hipFuncSetAttribute failed\n"); grid = -1; return; }
        if (hipOccupancyMaxActiveBlocksPerMultiprocessor(&per_cu, (const void*)fwd_megakernel, 512, LDS_BYTES) != hipSuccess || per_cu < 1) { fprintf(stderr, "kernel_launch: occupancy query gave %d\n", per_cu); per_cu = 1; }
        (void)hipGetLastError();
        grid = cus;
    }
    if (grid < 0) return;
    Params p{};
    p.xp = (const float*)d_in[0]; p.xs = (const float*)d_in[1]; p.w_in = (const float*)d_in[2]; p.w_out = (const float*)d_in[3]; p.g_attn = (const float*)d_in[4];
    p.g_na = (const float*)d_in[5]; p.g_dil = (const float*)d_in[6]; p.rpb = (const float*)d_in[7]; p.t5 = (const float*)d_in[8]; p.g_ffn = (const float*)d_in[9];
    p.w_gate = (const float*)d_in[10]; p.w_up = (const float*)d_in[11]; p.w_down = (const float*)d_in[12]; p.g_final = (const float*)d_in[13];
    p.out = (float*)d_out; p.ws = (unsigned char*)d_ws;
    void* args[] = {&p};
    hipError_t e = hipLaunchCooperativeKernel((const void*)fwd_megakernel, dim3(grid), dim3(512), args, LDS_BYTES, stream);
    if (e != hipSuccess) fprintf(stderr, "kernel_launch: cooperative launch failed: %s (grid %d)\n", hipGetErrorString(e), grid);
}
```

```cpp
#include <hip/hip_runtime.h>
#include <hip/hip_cooperative_groups.h>
#include <cstdio>
#include <cstdint>
#include <type_traits>
namespace cg = cooperative_groups;
__device__ __forceinline__ int ltid() { int t = threadIdx.x; asm volatile("" : "+v"(t)); return t; }
__device__ __forceinline__ int lbid() { extern __shared__ __attribute__((aligned(16))) char shm_dyn[]; int t = __builtin_amdgcn_readfirstlane(*(volatile int*)(shm_dyn + 131072 + 8)); asm volatile("" : "+s"(t)); return t; }
__device__ __forceinline__ int lgdim() { int t = gridDim.x; asm volatile("" : "+s"(t)); return t; }
namespace pg8 {
#define PG8_LAS __attribute__((address_space(3)))
typedef unsigned short bf16_t;
typedef short bf16x8 __attribute__((ext_vector_type(8)));
typedef float f32x4 __attribute__((ext_vector_type(4)));
typedef unsigned u32x4 __attribute__((ext_vector_type(4)));
constexpr int BM = 256, BK = 64, HALF = 128, HTB = HALF * BK * 2  , STAGE_BYTES = 8 * HTB, NXCD = 8, WGM = 8;

__host__ __device__ __forceinline__ int lds_byte(int r, int c) { const int st = (r >> 4) * 2 + (c >> 5), rr = r & 15, cc = c & 31, ob = rr * 64 + cc * 2; return st * 1024 + (ob ^ (((ob >> 9) & 1) << 5)); }
__host__ __device__ __forceinline__ void stage_rc(int b, int& R, int& C) { const int st = b / 1024, sb = b % 1024, swz = sb ^ (((sb >> 9) & 1) << 5); R = (st >> 1) * 16 + swz / 64; C = (st & 1) * 32 + (swz % 64) / 2; }
__host__ __device__ __forceinline__ int perm32(int rho) { const int n = rho >> 4, i = rho & 15; return 8 * (i >> 2) + 4 * n + (i & 3); }

struct Unit { int pm, pn; };
struct Gemm { const bf16_t* A; const bf16_t* Bt; int M, N, K, lda; };

struct StaticOrder {
    int nM, nN, nwg, G, c;
    __host__ __device__ void init(int M, int N, int G_, int c_) { nM = M / BM; nN = N / BM; nwg = nM * nN; G = G_; c = c_; }
    __host__ __device__ bool next(int i, Unit& u) const {
        const long L = (long)i * G + c; if (L >= nwg) return false;
        int wgid = (int)L; { const int q = nwg / NXCD, r = nwg % NXCD, xcd = wgid % NXCD, off = wgid / NXCD; wgid = (xcd < r ? xcd * (q + 1) : r * (q + 1) + (xcd - r) * q) + off; }
        const int nig = WGM * nN, gid = wgid / nig, fm = gid * WGM, gsz = (nM - fm) < WGM ? (nM - fm) : WGM;
        u.pm = fm + ((wgid % nig) % gsz); u.pn = (wgid % nig) / gsz; return true;
    }
    __device__ __forceinline__ void a_ready(const Unit&) const {}
    __device__ __forceinline__ void done(const Unit&) const {}
};
template <int NN> struct StaticOrderT {
    int nM, nwg, G, c;
    __host__ __device__ void init(int M, int  , int G_, int c_) { nM = M / BM; nwg = nM * NN; G = G_; c = c_; }
    __host__ __device__ bool next(int i, Unit& u) const {
        const int L = i * G + c; if (L >= nwg) return false;
        const int q = nwg / NXCD;
        const int wgid = (L % NXCD) * q + L / NXCD;
        constexpr int nig = WGM * NN; const int gid = wgid / nig, w = wgid % nig;
        u.pm = gid * WGM + (w % WGM); u.pn = w / WGM; return true;
    }
    __device__ __forceinline__ void a_ready(const Unit&) const {}
    __device__ __forceinline__ void done(const Unit&) const {}
};
__device__ __forceinline__ unsigned cvt_pk_bf16(float lo, float hi) { unsigned r; asm volatile("v_cvt_pk_bf16_f32 %0, %1, %2" : "=v"(r) : "v"(lo), "v"(hi)); return r; }
template <class Epi, class Sched, bool STAMP = false>
__device__ __forceinline__ void gemm_phase(PG8_LAS unsigned char* lds, const Gemm g, const Sched& S, const Epi& E, unsigned long long* stamps) {
    const int tid = ltid(), wid = __builtin_amdgcn_readfirstlane(tid >> 6), lane = tid & 63, wr = wid >> 2, wc = wid & 3, fr = lane & 15, fq = lane >> 4;
    const int K = g.K, nt = K / BK;
    int ts_lo = 0, ts_hi = 0, nts = 0; const unsigned long long rt_entry = STAMP ? (unsigned long long)wall_clock64() : 0ull;
#define PG8_STAMP() do { if (STAMP && wid == 0 && nts < 64) { const unsigned long long _c = (unsigned long long)clock64(); \
        ts_lo = (lane == nts) ? (int)(unsigned)_c : ts_lo; ts_hi = (lane == nts) ? (int)(unsigned)(_c >> 32) : ts_hi; ++nts; } } while (0)
    PG8_STAMP();
    unsigned voffA[2], voffB[2];
#pragma unroll
    for (int i = 0; i < 2; ++i) { int R, C; stage_rc(tid * 16 + i * 8192, R, C); const int Rb = Epi::PERM ? ((R & ~31) + perm32(R & 31)) : R;
        voffA[i] = (unsigned)(R * g.lda + C) * 2u; voffB[i] = (unsigned)(Rb * K + C) * 2u; }
    const size_t kstep = (size_t)(BK * 2);
    const size_t hstep = (size_t)HALF * K * 2;
    const size_t tstep = 2 * hstep; const size_t hstepA = (size_t)HALF * g.lda * 2, tstepA = 2 * hstepA;
    const unsigned ldsw = (unsigned)wid * 1024u;
    const int aoff = lds_byte(wr * 64 + fr, fq * 8), boff = lds_byte(wc * 32 + fr, fq * 8);
#define PG8_SA(b, h) (((b) * 2 + (h)) * HTB)
#define PG8_SB(b, h) ((4 + (b) * 2 + (h)) * HTB)
#define PG8_STAGE(bufoff, gbase, voff) do { _Pragma("unroll") for (int _i = 0; _i < 2; ++_i) \
        __builtin_amdgcn_global_load_lds((const unsigned*)((const char*)(gbase) + (voff)[_i]), (PG8_LAS unsigned*)(lds + (bufoff) + ldsw + _i * 8192), 16, 0, 0); } while (0)
#define PG8_LDA(dst, b, h) do { _Pragma("unroll") for (int m = 0; m < 4; ++m) _Pragma("unroll") for (int k = 0; k < 2; ++k) dst[m][k] = *(const PG8_LAS bf16x8*)(lds + PG8_SA(b, h) + aoff + m * 2048 + k * 1024); } while (0)
#define PG8_LDB(dst, b, h) do { _Pragma("unroll") for (int n = 0; n < 2; ++n) _Pragma("unroll") for (int k = 0; k < 2; ++k) dst[n][k] = *(const PG8_LAS bf16x8*)(lds + PG8_SB(b, h) + boff + n * 2048 + k * 1024); } while (0)
#define PG8_MMA(ai, bj, At, Bt) do { __builtin_amdgcn_s_setprio(1); _Pragma("unroll") for (int m = 0; m < 4; ++m) _Pragma("unroll") for (int n = 0; n < 2; ++n) _Pragma("unroll") for (int k = 0; k < 2; ++k) \
        acc[ai][bj][m][n] = __builtin_amdgcn_mfma_f32_16x16x32_bf16(Bt[n][k], At[m][k], acc[ai][bj][m][n], 0, 0, 0); __builtin_amdgcn_s_setprio(0); } while (0)
#define PG8_WAIT_V(n) asm volatile("s_waitcnt vmcnt(" #n ")" ::: "memory")
#define PG8_WAIT_L(n) asm volatile("s_waitcnt lgkmcnt(" #n ")" ::: "memory")
#define PG8_BAR __builtin_amdgcn_s_barrier()
#define PG8_SCHED __builtin_amdgcn_sched_barrier(0)
    Unit cur, nxt; int ui = 0;
    if (!S.next(0, cur)) return;
    f32x4 acc[2][2][4][2];
#pragma unroll
    for (int a = 0; a < 2; ++a)
#pragma unroll
        for (int b = 0; b < 2; ++b)
#pragma unroll
            for (int m = 0; m < 4; ++m)
#pragma unroll
                for (int n = 0; n < 2; ++n) acc[a][b][m][n] = (f32x4){0.f, 0.f, 0.f, 0.f};
    bf16x8 At[4][2], B0[2][2], B1[2][2];
    const char* cA = (const char*)g.A + (size_t)cur.pm * tstepA; const char* cB = (const char*)g.Bt + (size_t)cur.pn * tstep;
    S.a_ready(cur);
    PG8_STAGE(PG8_SB(0, 0), cB, voffB); PG8_STAGE(PG8_SA(0, 0), cA, voffA); PG8_STAGE(PG8_SB(0, 1), cB + hstep, voffB); PG8_STAGE(PG8_SA(0, 1), cA + hstepA, voffA);
    if (wr == 1) PG8_BAR;
    PG8_WAIT_V(4); PG8_BAR;
    PG8_STAGE(PG8_SB(1, 0), cB + kstep, voffB); PG8_STAGE(PG8_SA(1, 0), cA + kstep, voffA); PG8_STAGE(PG8_SB(1, 1), cB + hstep + kstep, voffB);
    PG8_WAIT_V(6); PG8_BAR;
    PG8_STAMP();
    typename Epi::State est;
    for (;;) {
        E.prefetch(cur, wr, wc, fr, fq, est);
        const bool has_next = S.next(ui + 1, nxt);
        const char* nA = has_next ? (const char*)g.A + (size_t)nxt.pm * tstepA : cA; const char* nB = has_next ? (const char*)g.Bt + (size_t)nxt.pn * tstep : cB;
        for (int t = 0; t < nt; t += 2) {
            const bool last = (t == nt - 2);
            const char* a1 = cA + (size_t)(t + 1) * kstep;
            const char* a2 = last ? nA : cA + (size_t)(t + 2) * kstep; const char* b2 = last ? nB : cB + (size_t)(t + 2) * kstep;
            const char* a3 = a2 + kstep; const char* b3 = b2 + kstep;
            if (last && has_next) S.a_ready(nxt);
            PG8_LDB(B0, 0, 0); PG8_SCHED; PG8_LDA(At, 0, 0); PG8_STAGE(PG8_SA(1, 1), a1 + hstepA, voffA);
            PG8_WAIT_L(8); PG8_BAR; PG8_WAIT_L(0); PG8_MMA(0, 0, At, B0); PG8_BAR; PG8_SCHED;
            PG8_LDB(B1, 0, 1); PG8_STAGE(PG8_SB(0, 0), b2, voffB);
            PG8_BAR; PG8_WAIT_L(0); PG8_MMA(0, 1, At, B1); PG8_BAR;
            PG8_LDA(At, 0, 1); PG8_STAGE(PG8_SA(0, 0), a2, voffA);
            PG8_BAR; PG8_WAIT_L(0); PG8_MMA(1, 0, At, B0); PG8_BAR; PG8_SCHED;
            PG8_STAGE(PG8_SB(0, 1), b2 + hstep, voffB);
            PG8_WAIT_V(6); PG8_BAR; PG8_MMA(1, 1, At, B1); PG8_BAR;
            PG8_LDB(B0, 1, 0); PG8_SCHED; PG8_LDA(At, 1, 0); PG8_STAGE(PG8_SA(0, 1), a2 + hstepA, voffA);
            PG8_WAIT_L(8); PG8_BAR; PG8_WAIT_L(0); PG8_MMA(0, 0, At, B0); PG8_BAR; PG8_SCHED;
            PG8_LDB(B1, 1, 1); PG8_STAGE(PG8_SB(1, 0), b3, voffB);
            PG8_BAR; PG8_WAIT_L(0); PG8_MMA(0, 1, At, B1); PG8_BAR;
            PG8_LDA(At, 1, 1); PG8_STAGE(PG8_SA(1, 0), a3, voffA);
            PG8_BAR; PG8_WAIT_L(0); PG8_MMA(1, 0, At, B0); PG8_BAR; PG8_SCHED;
            PG8_STAGE(PG8_SB(1, 1), b3 + hstep, voffB);
            PG8_WAIT_V(6); PG8_BAR; PG8_MMA(1, 1, At, B1); PG8_BAR;
        }
        PG8_STAMP();
        if constexpr (!Epi::AFTER_DRAIN) { E(acc, cur, wr, wc, fr, fq, est); S.done(cur); }
        PG8_STAMP();
        if (!has_next) break;
#pragma unroll
        for (int a = 0; a < 2; ++a)
#pragma unroll
            for (int b = 0; b < 2; ++b)
#pragma unroll
                for (int m = 0; m < 4; ++m)
#pragma unroll
                    for (int n = 0; n < 2; ++n) acc[a][b][m][n] = (f32x4){0.f, 0.f, 0.f, 0.f};
        cur = nxt; cA = nA; cB = nB; ++ui;
    }
    PG8_WAIT_V(0);
    if (wr == 0) PG8_BAR;
    PG8_BAR;
    if constexpr (Epi::AFTER_DRAIN) { E.fused(acc, cur, wr, wc, fr, fq, lds, wid, lane); S.done(cur); }
    PG8_STAMP();
    if (STAMP && wid == 0) { stamps[lane] = lane < nts ? (((unsigned long long)(unsigned)ts_hi << 32) | (unsigned)ts_lo) : 0ull;
        if (lane == 62) stamps[62] = rt_entry; if (lane == 63) stamps[63] = (unsigned long long)wall_clock64(); }
#undef PG8_STAMP
#undef PG8_SA
#undef PG8_SB
#undef PG8_STAGE
#undef PG8_LDA
#undef PG8_LDB
#undef PG8_MMA
#undef PG8_WAIT_V
#undef PG8_WAIT_L
#undef PG8_BAR
#undef PG8_SCHED
}
}
#define XB_TMO      128
#define XB_XCNT(j)  (256  + 64 * (j))
#define XB_XSUB(j)  (1280 + 64 * (j))
#define XB_XGEN(j)  (2304 + 64 * (j))
#define XB_TOP      3328
#define XB_TOPGEN   3392
#define XCD_BAR_WORDS 3456
#define XB_SPIN_CAP (1u << 18)
#define XLAS __attribute__((address_space(3)))

__device__ __forceinline__ unsigned xb_ld(unsigned* p)              { return __hip_atomic_load(p, __ATOMIC_RELAXED, __HIP_MEMORY_SCOPE_AGENT); }
__device__ __forceinline__ unsigned xb_add(unsigned* p, unsigned v) { return __hip_atomic_fetch_add(p, v, __ATOMIC_RELAXED, __HIP_MEMORY_SCOPE_AGENT); }
__device__ __forceinline__ unsigned xb_xcc_id() { return (unsigned)__builtin_amdgcn_s_getreg((3 << 11) | 20) & 0xFu; }
#define XB_SPIN(cond, bar) do { unsigned _sp = 0; while (cond) { __builtin_amdgcn_s_sleep(1); \
    if ((++_sp & 255u) == 0u) { if (xb_ld(&(bar)[XB_TMO])) break; if (_sp > XB_SPIN_CAP) { atomicAdd(&(bar)[XB_TMO], 1u); break; } } } } while (0)

struct XcdBarrier {
    unsigned* bar; unsigned x;
    volatile XLAS unsigned* st;
};

__device__ __forceinline__ XcdBarrier xcd_barrier_post(unsigned* bar, volatile XLAS unsigned* st) {
    XcdBarrier b; b.bar = bar; b.x = xb_xcc_id(); b.st = st;
    if (threadIdx.x == 0) { const unsigned rank = xb_add(&bar[XB_XCNT(b.x)], 1u); st[3] = rank; }
    return b;
}
__device__ __forceinline__ void xcd_barrier_complete(unsigned* bar, unsigned x, unsigned& nloc, unsigned& nx) {
    const unsigned G = gridDim.x * gridDim.y * gridDim.z;
    unsigned sum, cnt, mine, sp = 0u;
    for (;;) {
        sum = 0u; cnt = 0u; mine = 0u;
#pragma unroll
        for (unsigned j = 0; j < 16; ++j) { const unsigned c = xb_ld(&bar[XB_XCNT(j)]); sum += c; cnt += (c > 0u) ? 1u : 0u; mine = (j == x) ? c : mine; }
        if (sum == G) break;
        __builtin_amdgcn_s_sleep(1);
        if ((++sp & 255u) == 0u) { if (xb_ld(&bar[XB_TMO])) break; if (sp > XB_SPIN_CAP) { atomicAdd(&bar[XB_TMO], 1u); break; } }
    }
    nloc = mine > 0u ? mine : 1u; nx = cnt > 0u ? cnt : 1u;
}

__device__ __forceinline__ void xcd_barrier(const XcdBarrier& b) {
    asm volatile("s_waitcnt vmcnt(0)" ::: "memory");
    __syncthreads();
    if (threadIdx.x == 0) {
        unsigned* bar = b.bar;
        __builtin_amdgcn_s_waitcnt(0);
        unsigned nloc = b.st[0], nx = b.st[1];
        if (nloc == 0u) { xcd_barrier_complete(bar, b.x, nloc, nx); b.st[0] = nloc; b.st[1] = nx; }
        const unsigned old = xb_add(&bar[XB_XSUB(b.x)], 1u);
        const unsigned gen = old / nloc;
        if (old + 1u == (gen + 1u) * nloc) {
            __builtin_amdgcn_fence(__ATOMIC_RELEASE, "agent");
            asm volatile("s_waitcnt vmcnt(0)" ::: "memory");
            const unsigned og = xb_add(&bar[XB_TOP], 1u);
            const unsigned tg = og / nx;
            if (og + 1u == (tg + 1u) * nx) xb_add(&bar[XB_TOPGEN], 1u);
            else XB_SPIN(xb_ld(&bar[XB_TOPGEN]) == tg, bar);
            __builtin_amdgcn_fence(__ATOMIC_ACQUIRE, "agent");
            xb_add(&bar[XB_XGEN(b.x)], 1u);
            asm volatile("s_waitcnt vmcnt(0)" ::: "memory");
        } else {
            XB_SPIN(xb_ld(&bar[XB_XGEN(b.x)]) == gen, bar);
            __builtin_amdgcn_fence(__ATOMIC_ACQUIRE, "agent");
            asm volatile("s_waitcnt vmcnt(0)" ::: "memory");
        }
    }
    __syncthreads();
}

using pg8::bf16_t; using pg8::bf16x8; using pg8::f32x4; using pg8::u32x4;
typedef float f32x16 __attribute__((ext_vector_type(16)));
typedef short s16x4 __attribute__((ext_vector_type(4)));
typedef unsigned u32x2 __attribute__((ext_vector_type(2)));

constexpr int NTOK = 49152, DM = 2048, NQKV = 6144, DFF = 5632, LP = 16384, LS = 4096, DEPTH = 2;
constexpr float EPS = 1e-6f;
constexpr float SCALE = 0.08838834764831845f;
constexpr int LDS_BYTES = pg8::STAGE_BYTES + 8192;
constexpr size_t E_WIN = (size_t)NQKV * DM, E_WOUT = (size_t)DM * DM, E_WGU = (size_t)2 * DFF * DM, E_WDN = (size_t)DM * DFF;
constexpr size_t OFF_WIN = 0, OFF_WOUT = OFF_WIN + 2 * E_WIN, OFF_WGU = OFF_WOUT + 2 * E_WOUT, OFF_WDN = OFF_WGU + 2 * E_WGU, WT_LAYER = OFF_WDN + 2 * E_WDN, OFF_QKV = DEPTH * WT_LAYER;
constexpr size_t OFF_H = OFF_QKV + (size_t)NTOK * NQKV * 2, OFF_LSE = OFF_H + (size_t)NTOK * DM * 2, OFF_BAR = OFF_LSE + (size_t)3 * NTOK * 8 * 4, OFF_RSA = OFF_BAR + 16384, OFF_RSF = OFF_RSA + (size_t)NTOK * 8, WS_END = OFF_RSF + (size_t)NTOK * 8;

typedef unsigned long long u64;
constexpr float RS_FIX = 1048576.0f, RS_INV = 1.0f / 1048576.0f;
__device__ __forceinline__ float rs_rstd(u64 v) { return 1.0f / sqrtf((float)v * (RS_INV / DM) + EPS); }
#ifndef MK_NCHUNK
#define MK_NCHUNK 2
#endif
constexpr int NCHUNK = MK_NCHUNK;
__device__ __forceinline__ int chunk_t0(int c) { return NCHUNK == 3 ? c * 16384 : (c ? 16384 : 0); }
__device__ __forceinline__ int chunk_m(int c) { return NCHUNK == 3 ? 16384 : (c ? 32768 : 16384); }
__device__ __forceinline__ int chunk_of(int tok) { return NCHUNK == 3 ? tok >> 14 : (tok >= 16384 ? 1 : 0); }
struct Params {
    const float *xp, *xs, *w_in, *w_out, *g_attn, *g_na, *g_dil, *rpb, *t5, *g_ffn, *w_gate, *w_up, *w_down, *g_final;
    float* out; unsigned char* ws;
};

__device__ __forceinline__ unsigned pk2(float lo, float hi) { unsigned r; asm volatile("v_cvt_pk_bf16_f32 %0, %1, %2" : "=v"(r) : "v"(lo), "v"(hi)); return r; }
__device__ __forceinline__ float wave_sum(float v) {
#pragma unroll
    for (int o = 1; o < 64; o <<= 1) v += __shfl_xor(v, o);
    return v;
}
__device__ __forceinline__ const float* xrow(const Params& p, int layer, int row) {
    if (layer) return p.out + (size_t)row * DM;
    return row < LP ? p.xp + (size_t)row * DM : p.xs + (size_t)(row - LP) * DM;
}

__device__ __forceinline__ void transpose_item(const float* W, int K, int N, bf16_t* WT, int k0, int n0, int dst_row0, float* scr, int lane, const float* gk) {
    float wv[32];
#pragma unroll
    for (int i = 0; i < 32; ++i) { const int kk = 2 * i + (lane >> 5); wv[i] = W[(size_t)(k0 + kk) * N + n0 + (lane & 31)]; }
    if (gk) {
#pragma unroll
        for (int i = 0; i < 32; ++i) wv[i] *= gk[k0 + 2 * i + (lane >> 5)]; }
#pragma unroll
    for (int i = 0; i < 32; ++i) scr[(2 * i + (lane >> 5)) * 33 + (lane & 31)] = wv[i];
    asm volatile("s_waitcnt lgkmcnt(0)" ::: "memory");
    const int c = lane & 7;
#pragma unroll
    for (int j = 0; j < 4; ++j) { const int n = (lane >> 3) + 8 * j; const float* s = scr + (8 * c) * 33 + n;
        u32x4 o; o.x = pk2(s[0 * 33], s[1 * 33]); o.y = pk2(s[2 * 33], s[3 * 33]); o.z = pk2(s[4 * 33], s[5 * 33]); o.w = pk2(s[6 * 33], s[7 * 33]);
        *(u32x4*)(WT + (size_t)(dst_row0 + n) * K + k0 + 8 * c) = o; }
    asm volatile("s_waitcnt lgkmcnt(0)" ::: "memory");
}
__device__ __forceinline__ void phase_weights(const Params& p, int layer, char* lds, int gw, int ngw, int wid, int lane) {
    float* scr = (float*)(lds + wid * 8448);
    constexpr int I_IN = 32 * 192, I_OUT = 32 * 64, I_G = 32 * 176, I_D = 88 * 64, NIT = I_IN + I_OUT + 2 * I_G + I_D;
    unsigned char* wl = p.ws + (size_t)layer * WT_LAYER;
    bf16_t* wt_in = (bf16_t*)(wl + OFF_WIN); bf16_t* wt_out = (bf16_t*)(wl + OFF_WOUT); bf16_t* wt_gu = (bf16_t*)(wl + OFF_WGU); bf16_t* wt_dn = (bf16_t*)(wl + OFF_WDN);
    for (int it = gw; it < NIT; it += ngw) {
        int r = it;
        if (r < I_IN) { const int kb = r / 192, nb = r % 192; transpose_item(p.w_in + (size_t)layer * DM * NQKV, DM, NQKV, wt_in, 64 * kb, 32 * nb, 32 * nb, scr, lane, p.g_attn + layer * DM); continue; } r -= I_IN;
        if (r < I_OUT) { const int kb = r / 64, nb = r % 64; transpose_item(p.w_out + (size_t)layer * DM * DM, DM, DM, wt_out, 64 * kb, 32 * nb, 32 * nb, scr, lane, nullptr); continue; } r -= I_OUT;
        if (r < 2 * I_G) { const int up = r >= I_G; if (up) r -= I_G; const int kb = r / 176, nb = r % 176, n0 = 32 * nb;
            transpose_item((up ? p.w_up : p.w_gate) + (size_t)layer * DM * DFF, DM, DFF, wt_gu, 64 * kb, n0, (n0 >> 7) * 256 + (n0 & 127) + (up ? 128 : 0), scr, lane, p.g_ffn + layer * DM); continue; } r -= 2 * I_G;
        { const int kb = r / 64, nb = r % 64; transpose_item(p.w_down + (size_t)layer * DFF * DM, DFF, DM, wt_dn, 64 * kb, 32 * nb, 32 * nb, scr, lane, nullptr); }
    }
}
__device__ __forceinline__ void phase_cvt(const Params& p, int gw, int ngw, int lane) {
    bf16_t* H = (bf16_t*)(p.ws + OFF_H); u64* rsa = (u64*)(p.ws + OFF_RSA);
    for (int row = gw; row < NTOK; row += ngw) {
        const f32x4* xr = (const f32x4*)xrow(p, 0, row) + lane;
        f32x4 v[8]; float s = 0.f;
#pragma unroll
        for (int j = 0; j < 8; ++j) { v[j] = xr[64 * j]; s += (v[j].x * v[j].x + v[j].y * v[j].y) + (v[j].z * v[j].z + v[j].w * v[j].w); }
        u32x2* o = (u32x2*)(H + (size_t)row * DM) + lane;
#pragma unroll
        for (int j = 0; j < 8; ++j) { u32x2 w; w.x = pk2(v[j].x, v[j].y); w.y = pk2(v[j].z, v[j].w); o[64 * j] = w; }
        s = wave_sum(s);
        if (lane == 0) rsa[row] = (u64)(s * RS_FIX);
    }
}
__device__ __forceinline__ float bf_lo(unsigned w);
__device__ __forceinline__ float bf_hi(unsigned w);
__device__ __forceinline__ void phase_final(const Params& p, int r0, int r1, int gw, int ngw, int lane) {
    const f32x4* gr = (const f32x4*)p.g_final + 2 * lane; const u64* rsa = (const u64*)(p.ws + OFF_RSA);
    for (int row = r0 + gw; row < r1; row += ngw) {
        const u32x4* xr = (const u32x4*)(p.ws + OFF_H + (size_t)row * 4096) + lane;
        u32x4 v[4];
#pragma unroll
        for (int j = 0; j < 4; ++j) v[j] = xr[64 * j];
        const float rstd = rs_rstd(rsa[row]);
        f32x4* o = (f32x4*)(p.out + (size_t)row * DM) + 2 * lane;
#pragma unroll
        for (int j = 0; j < 4; ++j) { const f32x4 g0 = gr[128 * j], g1 = gr[128 * j + 1];
            o[128 * j] = (f32x4){bf_lo(v[j].x) * rstd * g0.x, bf_hi(v[j].x) * rstd * g0.y, bf_lo(v[j].y) * rstd * g0.z, bf_hi(v[j].y) * rstd * g0.w};
            o[128 * j + 1] = (f32x4){bf_lo(v[j].z) * rstd * g1.x, bf_hi(v[j].z) * rstd * g1.y, bf_lo(v[j].w) * rstd * g1.z, bf_hi(v[j].w) * rstd * g1.w}; }
    }
}
__device__ __forceinline__ float bf_lo(unsigned w) { return __uint_as_float(w << 16); }
__device__ __forceinline__ float bf_hi(unsigned w) { return __uint_as_float(w & 0xffff0000u); }
__device__ __forceinline__ void unpack8(const u32x4 a, float* v) { v[0] = bf_lo(a.x); v[1] = bf_hi(a.x); v[2] = bf_lo(a.y); v[3] = bf_hi(a.y); v[4] = bf_lo(a.z); v[5] = bf_hi(a.z); v[6] = bf_lo(a.w); v[7] = bf_hi(a.w); }
__device__ __forceinline__ void phase_mixnorm(const Params& p, int layer, int r0, int r1, int gw, int ngw, int lane) {
    bf16_t* qkv = (bf16_t*)(p.ws + OFF_QKV); u64* rsa = (u64*)(p.ws + OFF_RSA); u64* rsf = (u64*)(p.ws + OFF_RSF);
    const float* lse = (const float*)(p.ws + OFF_LSE);
    const f32x4* ga = (const f32x4*)(p.g_na + layer * 1024) + 4 * lane; const f32x4* gd = (const f32x4*)(p.g_dil + layer * 1024) + 4 * lane;
    for (int row = r0 + gw; row < r1; row += ngw) {
        bf16_t* qrow = qkv + (size_t)row * NQKV;
        const u32x4* pa = (const u32x4*)qrow + 2 * lane;
        const int c = chunk_of(row); const size_t ct0 = (size_t)chunk_t0(c), cm = (size_t)chunk_m(c), rl = ((size_t)row - ct0) * 2048;
        const unsigned char* b0p = layer ? p.ws + OFF_H + ct0 * 4096 : (const unsigned char*)p.out + ct0 * 8192; const unsigned char* b1p = layer ? p.ws + OFF_H + ct0 * 4096 + cm * 2048 : (const unsigned char*)p.out + ct0 * 8192 + cm * 6144;
        const u32x4* p0 = (const u32x4*)(b0p + rl) + 2 * lane; const u32x4* p1 = (const u32x4*)(b1p + rl) + 2 * lane;
        const u32x4* p2 = (const u32x4*)((const unsigned char*)p.out + ct0 * 8192 + cm * 4096 + rl) + 2 * lane;
        const u32x4 a0 = pa[0], a1 = pa[1], b00 = p0[0], b01 = p0[1], b10 = p1[0], b11 = p1[1], b20 = p2[0], b21 = p2[1];
        const size_t li = (size_t)row * 8 + (lane >> 3);
        const float l0 = lse[li], l1 = lse[(size_t)NTOK * 8 + li], l2 = lse[(size_t)2 * NTOK * 8 + li];
        const float mx = fmaxf(l0, fmaxf(l1, l2)); float w0 = __expf(l0 - mx), w1 = __expf(l1 - mx), w2 = __expf(l2 - mx); const float wi = 1.0f / (w0 + w1 + w2); w0 *= wi; w1 *= wi; w2 *= wi;
        float av[16], bv[16], t1[16], t2[16];
        unpack8(a0, av); unpack8(a1, av + 8); unpack8(b00, bv); unpack8(b01, bv + 8); unpack8(b10, t1); unpack8(b11, t1 + 8); unpack8(b20, t2); unpack8(b21, t2 + 8);
        float sa = 0.f, sb = 0.f;
#pragma unroll
        for (int j = 0; j < 16; ++j) { bv[j] = bv[j] * w0 + t1[j] * w1 + t2[j] * w2; sa += av[j] * av[j]; sb += bv[j] * bv[j]; }
        const float ra = 1.0f / sqrtf(wave_sum(sa) * (1.0f / 1024) + EPS), rb = 1.0f / sqrtf(wave_sum(sb) * (1.0f / 1024) + EPS);
        if (lane == 0) { rsa[row] = 0ull; rsf[row] = 0ull; }
        u32x4 wa[2], wb[2];
#pragma unroll
        for (int q = 0; q < 2; ++q) { const f32x4 g0 = ga[2 * q], g1 = ga[2 * q + 1], h0 = gd[2 * q], h1 = gd[2 * q + 1]; const float* a = av + 8 * q; const float* b = bv + 8 * q;
            wa[q].x = pk2(a[0] * ra * g0.x, a[1] * ra * g0.y); wa[q].y = pk2(a[2] * ra * g0.z, a[3] * ra * g0.w); wa[q].z = pk2(a[4] * ra * g1.x, a[5] * ra * g1.y); wa[q].w = pk2(a[6] * ra * g1.z, a[7] * ra * g1.w);
            wb[q].x = pk2(b[0] * rb * h0.x, b[1] * rb * h0.y); wb[q].y = pk2(b[2] * rb * h0.z, b[3] * rb * h0.w); wb[q].z = pk2(b[4] * rb * h1.x, b[5] * rb * h1.y); wb[q].w = pk2(b[6] * rb * h1.z, b[7] * rb * h1.w); }
        u32x4* m0 = (u32x4*)(qrow + 1024) + 2 * lane; u32x4* m1 = (u32x4*)(qrow + 2048) + 2 * lane;
        m0[0] = wa[0]; m0[1] = wa[1]; m1[0] = wb[0]; m1[1] = wb[1];
    }
}

struct EpiBf16Scale {
    static constexpr bool PERM = true, AFTER_DRAIN = false;
    bf16_t* O; int ldc; const u64* rowss;
    struct State { u64 v[2][4]; };
    __device__ __forceinline__ void prefetch(const pg8::Unit& u, int wr, int wc, int fr, int fq, State& s) const {
        const int row0 = u.pm * 256 + wr * 64 + fr;
#pragma unroll
        for (int ai = 0; ai < 2; ++ai)
#pragma unroll
            for (int m = 0; m < 4; ++m) s.v[ai][m] = *(const __attribute__((address_space(1))) u64*)(rowss + row0 + ai * 128 + m * 16);
    }
    __device__ __forceinline__ void operator()(const f32x4 (&acc)[2][2][4][2], const pg8::Unit& u, int wr, int wc, int fr, int fq, const State& s) const {
        const int row0 = u.pm * 256 + wr * 64 + fr, col0 = u.pn * 256 + wc * 32 + 8 * fq;
#pragma unroll
        for (int ai = 0; ai < 2; ++ai)
#pragma unroll
            for (int m = 0; m < 4; ++m) { const int row = row0 + ai * 128 + m * 16; bf16_t* rowp = O + (size_t)row * ldc + col0;
                const float rs = rs_rstd(s.v[ai][m]);
#pragma unroll
                for (int bj = 0; bj < 2; ++bj) { const f32x4 v0 = acc[ai][bj][m][0] * rs, v1 = acc[ai][bj][m][1] * rs;
                    u32x4 w; w.x = pk2(v0[0], v0[1]); w.y = pk2(v0[2], v0[3]); w.z = pk2(v1[0], v1[1]); w.w = pk2(v1[2], v1[3]);
                    *(u32x4*)(rowp + bj * 128) = w; } }
    }
};
template <bool BASE_BF16> struct EpiResid {
    static constexpr bool PERM = true, AFTER_DRAIN = false;
    const float* base; const bf16_t* bsrc; float* out; bf16_t* xb; u64* rowss;
    struct State { u32x4 bb[2][2]; };
    __device__ __forceinline__ void prefetch(const pg8::Unit& u, int wr, int wc, int fr, int fq, State& s) const {
        const int row0 = u.pm * 256 + wr * 64 + fr, col0 = u.pn * 256 + wc * 32 + 8 * fq;
#pragma unroll
        for (int mm = 0; mm < 2; ++mm) { const size_t off = (size_t)(row0 + mm * 16) * DM + col0;
#pragma unroll
            for (int bj = 0; bj < 2; ++bj) { if (BASE_BF16) s.bb[mm][bj] = *(const __attribute__((address_space(1))) u32x4*)(bsrc + off + bj * 128); } }
    }
    __device__ __forceinline__ void operator()(const f32x4 (&acc)[2][2][4][2], const pg8::Unit& u, int wr, int wc, int fr, int fq, const State& s) const {
        const int row0 = u.pm * 256 + wr * 64 + fr, col0 = u.pn * 256 + wc * 32 + 8 * fq;
        f32x4 b[2][2][2][2];
        u32x4 bb[2][2][2];
#define EPI_LOADG(g, d, dd) do { _Pragma("unroll") for (int mm = 0; mm < 2; ++mm) { const size_t off = (size_t)(row0 + ((g) >> 1) * 128 + (((g) & 1) * 2 + mm) * 16) * DM + col0; \
        _Pragma("unroll") for (int bj = 0; bj < 2; ++bj) { if (BASE_BF16) dd[mm][bj] = *(const u32x4*)(bsrc + off + bj * 128); \
            else { d[mm][bj][0] = *(const f32x4*)(base + off + bj * 128); d[mm][bj][1] = *(const f32x4*)(base + off + bj * 128 + 4); } } } } while (0)
        if (BASE_BF16) {
#pragma unroll
            for (int mm = 0; mm < 2; ++mm)
#pragma unroll
                for (int bj = 0; bj < 2; ++bj) bb[0][mm][bj] = s.bb[mm][bj]; }
        else EPI_LOADG(0, b[0], bb[0]);
#pragma unroll
        for (int g = 0; g < 4; ++g) {
            if (g + 1 < 4) EPI_LOADG(g + 1, b[(g + 1) & 1], bb[(g + 1) & 1]);
            asm volatile("" ::: "memory");
#pragma unroll
            for (int mm = 0; mm < 2; ++mm) { const int ai = g >> 1, m = (g & 1) * 2 + mm, row = row0 + ai * 128 + m * 16; const size_t off = (size_t)row * DM + col0; float ss = 0.f;
#pragma unroll
                for (int bj = 0; bj < 2; ++bj) { f32x4 r0, r1;
                    if (BASE_BF16) { const u32x4 q = bb[g & 1][mm][bj]; r0 = (f32x4){bf_lo(q.x), bf_hi(q.x), bf_lo(q.y), bf_hi(q.y)}; r1 = (f32x4){bf_lo(q.z), bf_hi(q.z), bf_lo(q.w), bf_hi(q.w)}; }
                    else { r0 = b[g & 1][mm][bj][0]; r1 = b[g & 1][mm][bj][1]; }
                    const f32x4 v0 = r0 + acc[ai][bj][m][0], v1 = r1 + acc[ai][bj][m][1];
                    if (out) { *(f32x4*)(out + off + bj * 128) = v0; *(f32x4*)(out + off + bj * 128 + 4) = v1; }
                    u32x4 w; w.x = pk2(v0[0], v0[1]); w.y = pk2(v0[2], v0[3]); w.z = pk2(v1[0], v1[1]); w.w = pk2(v1[2], v1[3]); *(u32x4*)(xb + off + bj * 128) = w;
                    ss += ((v0[0] * v0[0] + v0[1] * v0[1]) + (v0[2] * v0[2] + v0[3] * v0[3])) + ((v1[0] * v1[0] + v1[1] * v1[1]) + (v1[2] * v1[2] + v1[3] * v1[3])); }
                ss += __shfl_xor(ss, 16); ss += __shfl_xor(ss, 32);
                if (fq == 0) (void)__hip_atomic_fetch_add(rowss + row, (u64)(ss * RS_FIX), __ATOMIC_RELAXED, __HIP_MEMORY_SCOPE_AGENT); }
            asm volatile("" ::: "memory");
        }
#undef EPI_LOADG
    }
};
__device__ __forceinline__ float silu_mul(float g, float u) { return g * u * __builtin_amdgcn_rcpf(1.0f + __builtin_amdgcn_exp2f(-1.4426950408889634f * g)); }
struct EpiSwiGLU {
    static constexpr bool PERM = true, AFTER_DRAIN = false;
    bf16_t* O; const u64* rowss;
    struct State { u64 v[2][4]; };
    __device__ __forceinline__ void prefetch(const pg8::Unit& u, int wr, int wc, int fr, int fq, State& s) const {
        const int row0 = u.pm * 256 + wr * 64 + fr;
#pragma unroll
        for (int ai = 0; ai < 2; ++ai)
#pragma unroll
            for (int m = 0; m < 4; ++m) s.v[ai][m] = *(const __attribute__((address_space(1))) u64*)(rowss + row0 + ai * 128 + m * 16);
    }
    __device__ __forceinline__ void operator()(const f32x4 (&acc)[2][2][4][2], const pg8::Unit& u, int wr, int wc, int fr, int fq, const State& s) const {
        const int row0 = u.pm * 256 + wr * 64 + fr, col0 = u.pn * 128 + wc * 32 + 8 * fq;
#pragma unroll
        for (int ai = 0; ai < 2; ++ai)
#pragma unroll
            for (int m = 0; m < 4; ++m) { const int row = row0 + ai * 128 + m * 16; bf16_t* rowp = O + (size_t)row * DFF + col0;
                const float rs = rs_rstd(s.v[ai][m]);
                const f32x4 g0 = acc[ai][0][m][0] * rs, g1 = acc[ai][0][m][1] * rs, u0 = acc[ai][1][m][0] * rs, u1 = acc[ai][1][m][1] * rs;
                u32x4 w; w.x = pk2(silu_mul(g0[0], u0[0]), silu_mul(g0[1], u0[1])); w.y = pk2(silu_mul(g0[2], u0[2]), silu_mul(g0[3], u0[3]));
                w.z = pk2(silu_mul(g1[0], u1[0]), silu_mul(g1[1], u1[1])); w.w = pk2(silu_mul(g1[2], u1[2]), silu_mul(g1[3], u1[3]));
                *(u32x4*)rowp = w; }
    }
};
#define KSWZ(row, colB) ((row) * 256 + ((colB) ^ (((row) & 7) << 4)))
#define SBAR() __builtin_amdgcn_sched_barrier(0)
__device__ __forceinline__ int crow(int r, int hi) { return (r & 3) + 8 * (r >> 2) + 4 * hi; }
__device__ __forceinline__ void qkt(f32x16& p0, f32x16& p1, const char* Ks, const bf16x8* qr, int r32, int hi) {
    p0 = f32x16{}; p1 = f32x16{};
#pragma unroll
    for (int d0 = 0; d0 < 8; ++d0) { const int cb = (d0 * 16 + hi * 8) * 2;
        const bf16x8 b0 = *reinterpret_cast<const bf16x8*>(Ks + KSWZ(r32, cb));
        const bf16x8 b1 = *reinterpret_cast<const bf16x8*>(Ks + KSWZ(32 + r32, cb));
        p0 = __builtin_amdgcn_mfma_f32_32x32x16_bf16(b0, qr[d0], p0, 0, 0, 0);
        p1 = __builtin_amdgcn_mfma_f32_32x32x16_bf16(b1, qr[d0], p1, 0, 0, 0); }
}
__device__ __forceinline__ int v_st(int k, int c) { const int kk = (k & ~0xC) | ((k & 4) << 1) | ((k & 8) >> 1); return ((kk >> 3) * 4 + (c >> 5)) * 512 + ((kk & 7) * 32 + (c & 31)) * 2; }
__device__ __forceinline__ int v_rd_base(int lane) { return ((lane & 3) << 3) | (((lane >> 2) & 3) << 6) | (((lane >> 4) & 1) << 5) | (((lane >> 5) & 1) << 8); }
constexpr int v_rd_off(int d0, int ks, int half) { return d0 * 512 + ks * 4096 + half * 2048; }
template <int OFF> __device__ __forceinline__ s16x4 tr_read(int vb) {
    s16x4 r; asm volatile("ds_read_b64_tr_b16 %0, %1 offset:%2" : "=&v"(r) : "v"(vb), "i"(OFF) : "memory"); return r;
}
template <int D0> __device__ __forceinline__ void pv_one(f32x16& od, int vb, bf16x8 pa0, bf16x8 pa1, bf16x8 pa2, bf16x8 pa3) {
    const s16x4 l0 = tr_read<v_rd_off(D0, 0, 0)>(vb), h0 = tr_read<v_rd_off(D0, 0, 1)>(vb), l1 = tr_read<v_rd_off(D0, 1, 0)>(vb), h1 = tr_read<v_rd_off(D0, 1, 1)>(vb);
    const s16x4 l2 = tr_read<v_rd_off(D0, 2, 0)>(vb), h2 = tr_read<v_rd_off(D0, 2, 1)>(vb), l3 = tr_read<v_rd_off(D0, 3, 0)>(vb), h3 = tr_read<v_rd_off(D0, 3, 1)>(vb);
    asm volatile("s_waitcnt lgkmcnt(0)" ::: "memory"); SBAR();
#define PK(L, H) (bf16x8){L[0], L[1], L[2], L[3], H[0], H[1], H[2], H[3]}
    od = __builtin_amdgcn_mfma_f32_32x32x16_bf16(pa0, PK(l0, h0), od, 0, 0, 0);
    od = __builtin_amdgcn_mfma_f32_32x32x16_bf16(pa1, PK(l1, h1), od, 0, 0, 0);
    od = __builtin_amdgcn_mfma_f32_32x32x16_bf16(pa2, PK(l2, h2), od, 0, 0, 0);
    od = __builtin_amdgcn_mfma_f32_32x32x16_bf16(pa3, PK(l3, h3), od, 0, 0, 0);
#undef PK
}
__device__ __forceinline__ int t5_bucket(int rel) {
    const int n = rel < 0 ? -rel : rel;
    int b = n;
    if (n >= 8) { b = 5 + (31 - __builtin_clz(n)); if (b > 15) b = 15; }
    return b + (rel > 0 ? 16 : 0);
}

#define GAS __attribute__((address_space(1)))
__device__ __forceinline__ bf16_t* dil_buf(const Params& p, int c, int dsel, int layer) {
    const size_t ct0 = (size_t)chunk_t0(c), cm = (size_t)chunk_m(c);
    unsigned char* dsl = (unsigned char*)p.out + ct0 * 8192;
    if (dsel == 2) return (bf16_t*)(dsl + cm * 4096);
    if (layer == 0) return (bf16_t*)(dsel == 0 ? dsl : dsl + cm * 6144);
    return (bf16_t*)(p.ws + OFF_H + ct0 * 4096 + (size_t)dsel * cm * 2048);
}
template <bool NA>
__device__ __forceinline__ void attn_item(const Params& p, int layer, int dsel, int item, char* lds) {
    const int tid = ltid(), wid = __builtin_amdgcn_readfirstlane(tid >> 6), lane = tid & 63, r32 = lane & 31, hi = lane >> 5;
    bf16_t* qkv = (bf16_t*)(p.ws + OFF_QKV);
    float* wsf = (float*)(lds + 131072 + 256) + wid * 64; float* li_l = wsf; float* al_l = wsf + 32;
    float* T = (float*)(lds + 131072 + 256 + 2048);
    const float NINF = -__builtin_inff();
    const int h = item & 7, gb = item >> 3;
    int base, L, lb;
    if (gb < 64) { base = 0; L = LP; lb = gb; } else { const int s = (gb - 64) >> 4; lb = (gb - 64) & 15; base = LP + s * LS; L = LS; }
    const int dshift = NA ? 0 : 2 * dsel, d = 1 << dshift;
    const int nbr = (L >> 8) >> dshift;
    const int res = NA ? 0 : lb / nbr, b = NA ? lb : lb % nbr;
    const int q0 = b * 256, Lsub = L >> dshift;
    const int colq = (NA ? 0 : 3072) + h * 128, colk = colq + 1024, colv = colq + 2048;
    const int tok0 = base + res;
    int tlo, thi, kr0 = 0, rq = 0, off = wid >> 1;
    if (NA) { const int rows = L >> 6, r0 = 4 * lb; kr0 = min(max(r0 - 4, 0), rows - 8); const int kr3 = min(max(r0 + 3 - 4, 0), rows - 8); tlo = 0; thi = kr3 + 8 - kr0;
        rq = r0 + (wid >> 1); off = min(max(rq - 4, 0), rows - 8) - kr0; }
    else { tlo = (q0 == 0) ? 1 : 0; thi = (q0 + 256 == Lsub) ? 5 : 6; }
    const int S = NA ? 8 : 3;
    const int sr = tid >> 4, sc = (tid & 15) * 8, vst0 = v_st(sr, sc), vst1 = v_st(32 + sr, sc), kst0 = KSWZ(sr, sc * 2), kst1 = KSWZ(32 + sr, sc * 2);
#define KT(t) (NA ? (kr0 + (t)) * 64 : q0 - 64 + 64 * (t))
#define SLOAD(t, R) do { const bf16_t* r0p = qkv + (size_t)(tok0 + (KT(t) + sr) * d) * NQKV + sc; const bf16_t* r1p = r0p + (size_t)32 * d * NQKV; \
    R[0] = *(const GAS bf16x8*)(r0p + colk); R[1] = *(const GAS bf16x8*)(r1p + colk); R[2] = *(const GAS bf16x8*)(r0p + colv); R[3] = *(const GAS bf16x8*)(r1p + colv); } while (0)
#define SWRITE(bi, R) do { char* bb = lds + (bi) * 32768; *(bf16x8*)(bb + vst0) = R[2]; *(bf16x8*)(bb + vst1) = R[3]; *(bf16x8*)(bb + 16384 + kst0) = R[0]; *(bf16x8*)(bb + 16384 + kst1) = R[1]; } while (0)
    bf16x8 st[4][4];
#pragma unroll
    for (int i = 0; i < 4; ++i) if (i >= tlo && i < thi) SLOAD(i, st[i]);
    bf16x8 qr[8];
    { const bf16_t* Qw = qkv + (size_t)(tok0 + (q0 + wid * 32 + r32) * d) * NQKV + colq + hi * 8;
#pragma unroll
      for (int d0 = 0; d0 < 8; ++d0) qr[d0] = *(const GAS bf16x8*)(Qw + d0 * 16); }
    float tv0 = 0.f, tv1 = 0.f;
    if (NA) { const int i0 = tid - 48, i1 = tid + 512 - 48; if (i0 >= 0 && i0 < 465) tv0 = p.rpb[((size_t)layer * 465 + i0) * 8 + h] * (1.0f / SCALE); if (tid < 64 && i1 < 465) tv1 = p.rpb[((size_t)layer * 465 + i1) * 8 + h] * (1.0f / SCALE); }
    else { const int j = tid - 128; tv0 = (tid < 256 && j >= -64 && j <= 64) ? p.t5[t5_bucket(d * j) * 8 + h] * (1.0f / SCALE) : NINF; }
    __syncthreads();
    if (NA) { T[tid] = tv0; if (tid < 64) T[tid + 512] = tv1; } else { if (tid < 256) T[tid] = tv0; }
#pragma unroll
    for (int i = 0; i < 4; ++i) if (i >= tlo && i < thi) SWRITE(i, st[i]);
    const int cq = 32 * (wid & 1) + r32, clo = min(max(cq - 8, 0), 48);
    unsigned vmask = 0;
    if (NA) {
#pragma unroll
        for (int r = 0; r < 16; ++r) { const int ck = crow(r, hi); if ((unsigned)(ck - clo) < 16u) vmask |= 1u << r; if ((unsigned)(ck + 32 - clo) < 16u) vmask |= 1u << (16 + r); } }
    const int vrb = (int)(uintptr_t)lds + v_rd_base(lane);
    float m_reg = -1e30f, l_reg = 0.f; f32x16 o[4] = {};
    constexpr float C = SCALE * 1.4426950408889634f;
    for (int s = 0; s < S; ++s) {
        __syncthreads();
        const bool ld = (s + 1 < S) && (s + 4 < thi);
        if (ld) SLOAD(s + 4, st[0]);
        const int t = off + s;
        if (t >= tlo && t < thi) {
            const char* Kb = lds + (t & 3) * 32768 + 16384; const int vb0 = vrb + (t & 3) * 32768;
            f32x16 p0, p1;
            qkt(p0, p1, Kb, qr, r32, hi);
            if (NA) { const float* Tb = T + 48 + (kr0 + t - rq + 7) * 31 + 15 - cq + 4 * hi;
#pragma unroll
                for (int r = 0; r < 16; ++r) { const int oo = (r & 3) + 8 * (r >> 2); const float b0 = Tb[oo], b1 = Tb[oo + 32];
                    p0[r] = ((vmask >> r) & 1u) ? p0[r] + b0 : NINF; p1[r] = ((vmask >> (16 + r)) & 1u) ? p1[r] + b1 : NINF; } }
            else { const float* Tb = T + (KT(t) - (q0 + 32 * wid) - r32 + 128 + 4 * hi);
#pragma unroll
                for (int r = 0; r < 16; ++r) { const int oo = (r & 3) + 8 * (r >> 2); p0[r] += Tb[oo]; p1[r] += Tb[oo + 32]; } }
            float pmax = p0[0];
#pragma unroll
            for (int r = 1; r < 16; ++r) pmax = fmaxf(pmax, p0[r]);
#pragma unroll
            for (int r = 0; r < 16; ++r) pmax = fmaxf(pmax, p1[r]);
            { auto rr = __builtin_amdgcn_permlane32_swap(__float_as_uint(pmax), __float_as_uint(pmax), false, false);
              pmax = fmaxf(__uint_as_float(rr[0]), __uint_as_float(rr[1])); }
            float mn = m_reg, alpha = 1.f;
            if (!__all(pmax - m_reg <= 8.0f / SCALE)) { mn = fmaxf(m_reg, pmax); alpha = __builtin_amdgcn_exp2f((m_reg - mn) * C); m_reg = mn; }
            const float mnC = -mn * C;
            float ps = 0.f;
#pragma unroll
            for (int r = 0; r < 16; ++r) { p0[r] = __builtin_amdgcn_exp2f(fmaf(p0[r], C, mnC)); p1[r] = __builtin_amdgcn_exp2f(fmaf(p1[r], C, mnC)); ps += p0[r] + p1[r]; }
            { auto rr = __builtin_amdgcn_permlane32_swap(__float_as_uint(ps), __float_as_uint(ps), false, false);
              ps = __uint_as_float(rr[0]) + __uint_as_float(rr[1]); }
            l_reg = l_reg * alpha + ps;
            bf16x8 pa0, pa1, pa2, pa3;
#define PK4(P, BASE, OUT) do { unsigned a0 = pk2(P[BASE + 0], P[BASE + 1]), a1 = pk2(P[BASE + 2], P[BASE + 3]);   \
    unsigned b0 = pk2(P[BASE + 4], P[BASE + 5]), b1 = pk2(P[BASE + 6], P[BASE + 7]);                              \
    auto r0 = __builtin_amdgcn_permlane32_swap(a0, b0, false, false); auto r1 = __builtin_amdgcn_permlane32_swap(a1, b1, false, false); \
    u32x4 w = {r0[0], r1[0], r0[1], r1[1]}; OUT = *reinterpret_cast<bf16x8*>(&w); } while (0)
            PK4(p0, 0, pa0); PK4(p0, 8, pa1); PK4(p1, 0, pa2); PK4(p1, 8, pa3);
#undef PK4
            if (__any(alpha < 1.f)) { if (hi == 0) al_l[r32] = alpha; asm volatile("s_waitcnt lgkmcnt(0)" ::: "memory");
#pragma unroll
                for (int r = 0; r < 16; ++r) { const float a = al_l[crow(r, hi)];
#pragma unroll
                    for (int dd = 0; dd < 4; ++dd) o[dd][r] *= a; } }
            pv_one<0>(o[0], vb0, pa0, pa1, pa2, pa3); pv_one<1>(o[1], vb0, pa0, pa1, pa2, pa3); pv_one<2>(o[2], vb0, pa0, pa1, pa2, pa3); pv_one<3>(o[3], vb0, pa0, pa1, pa2, pa3);
        }
        if (ld) { __syncthreads();
            SWRITE(s & 3, st[0]); }
    }
#undef SLOAD
#undef SWRITE
#undef KT
    if (hi == 0) li_l[r32] = l_reg; asm volatile("s_waitcnt lgkmcnt(0)" ::: "memory");
    bf16_t* Ob; int ldo;
    if (NA) { Ob = qkv + colq; ldo = NQKV; }
    else { const int c = chunk_of(base); Ob = dil_buf(p, c, dsel, layer) - (size_t)chunk_t0(c) * 1024 + h * 128; ldo = 1024; }
    if (!NA && hi == 0) { float* lse = (float*)(p.ws + OFF_LSE) + (size_t)dsel * NTOK * 8; lse[(size_t)(tok0 + (q0 + wid * 32 + r32) * d) * 8 + h] = m_reg * SCALE + __logf(l_reg); }
#pragma unroll
    for (int r = 0; r < 16; ++r) { const int orow = crow(r, hi); const float rl = __builtin_amdgcn_rcpf(li_l[orow]);
        bf16_t* op = Ob + (size_t)(tok0 + (q0 + wid * 32 + orow) * d) * ldo + r32;
#pragma unroll
        for (int dd = 0; dd < 4; ++dd) { const unsigned w = pk2(o[dd][r] * rl, 0.f); op[dd * 32] = (bf16_t)(w & 0xffffu); } }
}
template <int N, class Epi>
__device__ __forceinline__ void run_gemm(char* lds, int M, const bf16_t* A, int lda, const bf16_t* Bt, int K, const Epi& E) {
    pg8::Gemm g; g.A = A; g.Bt = Bt; g.M = M; g.N = N; g.K = K; g.lda = lda;
    pg8::StaticOrderT<N / 256> S; S.init(M, N, lgdim(), lbid());
    pg8::gemm_phase<Epi, pg8::StaticOrderT<N / 256>, false>((PG8_LAS unsigned char*)lds, g, S, E, nullptr);
}

template <class T> __device__ __forceinline__ T* launder(T* x) { asm volatile("" : "+s"(x)); return x; }
__device__ __forceinline__ void run_phase(const Params& p0, int layer, int ph, int chunk, char* shm) {
    Params p = p0;
    p.ws = launder(p.ws); p.out = launder(p.out);
    const int tid = ltid(), wid = __builtin_amdgcn_readfirstlane(tid >> 6), lane = tid & 63;
    const int G = lgdim(), bid = lbid(), gw = bid * 8 + wid, ngw = G * 8;
    const int t0 = chunk_t0(chunk), CM = chunk_m(chunk), nit = CM / 256 * 8, it0 = t0 / 256 * 8;
    bf16_t* qkv = (bf16_t*)(p.ws + OFF_QKV) + (size_t)t0 * NQKV; bf16_t* Hb = (bf16_t*)(p.ws + OFF_H) + (size_t)t0 * DM; unsigned char* wl = p.ws + (size_t)layer * WT_LAYER;
    u64* rsa = (u64*)(p.ws + OFF_RSA) + t0; u64* rsf = (u64*)(p.ws + OFF_RSF) + t0;
    bf16_t* xs2 = (bf16_t*)(p.out + (size_t)t0 * DM);
    switch (ph) {
    case 0: phase_weights(p, 0, shm, gw, ngw, wid, lane); phase_weights(p, 1, shm, gw, ngw, wid, lane); phase_cvt(p, gw, ngw, lane); break;
    case 1: { EpiBf16Scale E; E.O = qkv; E.ldc = NQKV; E.rowss = rsa; run_gemm<NQKV>(shm, CM, layer ? xs2 : Hb, DM, (bf16_t*)(wl + OFF_WIN), DM, E); } break;
    case 2: for (int it = bid; it < 4 * nit; it += G) { if (it < nit) attn_item<true>(p, layer, 0, it0 + it, shm); else attn_item<false>(p, layer, (it - nit) / nit, it0 + (it - nit) % nit, shm); } break;
    case 6: phase_mixnorm(p, layer, t0, t0 + CM, gw, ngw, lane); break;
    case 7: { EpiResid<true> E; E.base = nullptr; E.bsrc = layer ? xs2 : Hb; E.out = nullptr; E.xb = Hb; E.rowss = rsf; run_gemm<DM>(shm, CM, qkv + 1024, NQKV, (bf16_t*)(wl + OFF_WOUT), DM, E); } break;
    case 9: { EpiSwiGLU E; E.O = (bf16_t*)(p.ws + OFF_QKV) + (size_t)t0 * DFF; E.rowss = rsf; run_gemm<2 * DFF>(shm, CM, Hb, DM, (bf16_t*)(wl + OFF_WGU), DM, E); } break;
    case 10: { EpiResid<true> E; E.base = nullptr; E.bsrc = Hb; E.out = nullptr; E.xb = layer + 1 < DEPTH ? xs2 : Hb; E.rowss = rsa; run_gemm<DM>(shm, CM, (bf16_t*)(p.ws + OFF_QKV) + (size_t)t0 * DFF, DFF, (bf16_t*)(wl + OFF_WDN), DFF, E); } break;
    default: phase_final(p, t0, t0 + CM, gw, ngw, lane); break;
    }
}
__global__ void __launch_bounds__(512) fwd_megakernel(Params p) {
    extern __shared__ __attribute__((aligned(16))) char shm[];
    cg::grid_group grid = cg::this_grid();
    volatile XLAS unsigned* st = (volatile XLAS unsigned*)(shm + pg8::STAGE_BYTES);
    if (threadIdx.x == 0) { st[0] = 0u; st[1] = 0u; st[2] = blockIdx.x; st[3] = 0u; }
    __syncthreads();
    const XcdBarrier xb = xcd_barrier_post((unsigned*)(p.ws + OFF_BAR), st);
    constexpr int PER_CHUNK = 6 * DEPTH + 1, NSTEP = 1 + NCHUNK * PER_CHUNK;
    for (int step = 0; step < NSTEP; ++step) {
        int layer = 0, ph = 0, chunk = 0;
        if (step > 0) { chunk = (step - 1) / PER_CHUNK; const int sc = (step - 1) % PER_CHUNK;
            if (sc == PER_CHUNK - 1) ph = 11; else { layer = sc / 6; const int s6 = sc % 6; ph = s6 < 2 ? s6 + 1 : (s6 == 2 ? 6 : (s6 == 3 ? 7 : s6 + 5)); } }
        run_phase(p, layer, ph, chunk, shm);
        if (step == 0) { grid.sync();
            if (threadIdx.x == 0) { unsigned* bar = (unsigned*)(p.ws + OFF_BAR); bool ok = (gridDim.x & 7u) == 0u;
                for (unsigned j = 0; j < 8; ++j) ok = ok && (xb_ld(&bar[XB_XCNT(j)]) == gridDim.x / 8u);
                if (ok) st[2] = st[3] * 8u + xb.x; }
            __syncthreads(); }
        else if (step + 1 < NSTEP) xcd_barrier(xb);
    }
}

extern "C" void kernel_launch(void* const* d_in, const int* in_sizes, int n_in, void* d_out, int out_size, void* d_ws, size_t ws_size, hipStream_t stream) {
    static int grid = 0;
    if (grid == 0) {
        if (n_in != 14 || ws_size < WS_END) { fprintf(stderr, "kernel_launch: need 14 inputs and %zu bytes of workspace, got %d / %zu\n", (size_t)WS_END, n_in, ws_size); grid = -1; return; }
        int dev = 0, cus = 0, per_cu = 0;
        if (hipGetDevice(&dev) != hipSuccess || hipDeviceGetAttribute(&cus, hipDeviceAttributeMultiprocessorCount, dev) != hipSuccess) { grid = -1; return; }
        if (hipFuncSetAttribute((const void*)fwd_megakernel, hipFuncAttributeMaxDynamicSharedMemorySize, LDS_BYTES) != hipSuccess) { fprintf(stderr, "kernel_launch: hipFuncSetAttribute failed\n"); grid = -1; return; }
        if (hipOccupancyMaxActiveBlocksPerMultiprocessor(&per_cu, (const void*)fwd_megakernel, 512, LDS_BYTES) != hipSuccess || per_cu < 1) { fprintf(stderr, "kernel_launch: occupancy query gave %d\n", per_cu); per_cu = 1; }
        (void)hipGetLastError();
        grid = cus;
    }
    if (grid < 0) return;
    Params p{};
    p.xp = (const float*)d_in[0]; p.xs = (const float*)d_in[1]; p.w_in = (const float*)d_in[2]; p.w_out = (const float*)d_in[3]; p.g_attn = (const float*)d_in[4];
    p.g_na = (const float*)d_in[5]; p.g_dil = (const float*)d_in[6]; p.rpb = (const float*)d_in[7]; p.t5 = (const float*)d_in[8]; p.g_ffn = (const float*)d_in[9];
    p.w_gate = (const float*)d_in[10]; p.w_up = (const float*)d_in[11]; p.w_down = (const float*)d_in[12]; p.g_final = (const float*)d_in[13];
    p.out = (float*)d_out; p.ws = (unsigned char*)d_ws;
    if (hipMemsetAsync((char*)d_ws + OFF_BAR, 0, 16384, stream) != hipSuccess) { fprintf(stderr, "kernel_launch: memset failed\n"); return; }
    void* args[] = {&p};
    hipError_t e = hipLaunchCooperativeKernel((const void*)fwd_megakernel, dim3(grid), dim3(512), args, LDS_BYTES, stream);
    if (e != hipSuccess) fprintf(stderr, "kernel_launch: cooperative launch failed: %s (grid %d)\n", hipGetErrorString(e), grid);
}
```

```cpp
#include <hip/hip_runtime.h>
#include <hip/hip_cooperative_groups.h>
#include <cstdio>
#include <cstdint>
#include <type_traits>
namespace cg = cooperative_groups;
__device__ __forceinline__ int ltid() { int t = threadIdx.x; asm volatile("" : "+v"(t)); return t; }
__device__ __forceinline__ int lbid() { extern __shared__ __attribute__((aligned(16))) char shm_dyn[]; int t = __builtin_amdgcn_readfirstlane(*(volatile int*)(shm_dyn + 131072 + 8)); asm volatile("" : "+s"(t)); return t; }
__device__ __forceinline__ int lgdim() { int t = gridDim.x; asm volatile("" : "+s"(t)); return t; }
namespace pg8 {
#define PG8_LAS __attribute__((address_space(3)))
typedef unsigned short bf16_t;
typedef short bf16x8 __attribute__((ext_vector_type(8)));
typedef float f32x4 __attribute__((ext_vector_type(4)));
typedef unsigned u32x4 __attribute__((ext_vector_type(4)));
constexpr int BM = 256, BK = 64, HALF = 128, HTB = HALF * BK * 2  , STAGE_BYTES = 8 * HTB, NXCD = 8, WGM = 8;

__host__ __device__ __forceinline__ int lds_byte(int r, int c) { const int st = (r >> 4) * 2 + (c >> 5), rr = r & 15, cc = c & 31, ob = rr * 64 + cc * 2; return st * 1024 + (ob ^ (((ob >> 9) & 1) << 5)); }
__host__ __device__ __forceinline__ void stage_rc(int b, int& R, int& C) { const int st = b / 1024, sb = b % 1024, swz = sb ^ (((sb >> 9) & 1) << 5); R = (st >> 1) * 16 + swz / 64; C = (st & 1) * 32 + (swz % 64) / 2; }
__host__ __device__ __forceinline__ int perm32(int rho) { const int n = rho >> 4, i = rho & 15; return 8 * (i >> 2) + 4 * n + (i & 3); }

struct Unit { int pm, pn; };
struct Gemm { const bf16_t* A; const bf16_t* Bt; int M, N, K, lda; };

struct StaticOrder {
    int nM, nN, nwg, G, c;
    __host__ __device__ void init(int M, int N, int G_, int c_) { nM = M / BM; nN = N / BM; nwg = nM * nN; G = G_; c = c_; }
    __host__ __device__ bool next(int i, Unit& u) const {
        const long L = (long)i * G + c; if (L >= nwg) return false;
        int wgid = (int)L; { const int q = nwg / NXCD, r = nwg % NXCD, xcd = wgid % NXCD, off = wgid / NXCD; wgid = (xcd < r ? xcd * (q + 1) : r * (q + 1) + (xcd - r) * q) + off; }
        const int nig = WGM * nN, gid = wgid / nig, fm = gid * WGM, gsz = (nM - fm) < WGM ? (nM - fm) : WGM;
        u.pm = fm + ((wgid % nig) % gsz); u.pn = (wgid % nig) / gsz; return true;
    }
    __device__ __forceinline__ void a_ready(const Unit&) const {}
    __device__ __forceinline__ void done(const Unit&) const {}
};
__device__ __forceinline__ unsigned cvt_pk_bf16(float lo, float hi) { unsigned r; asm volatile("v_cvt_pk_bf16_f32 %0, %1, %2" : "=v"(r) : "v"(lo), "v"(hi)); return r; }
template <class Epi, class Sched, bool STAMP = false>
__device__ __forceinline__ void gemm_phase(PG8_LAS unsigned char* lds, const Gemm g, const Sched& S, const Epi& E, unsigned long long* stamps) {
    const int tid = ltid(), wid = __builtin_amdgcn_readfirstlane(tid >> 6), lane = tid & 63, wr = wid >> 2, wc = wid & 3, fr = lane & 15, fq = lane >> 4;
    const int K = g.K, nt = K / BK;
    int ts_lo = 0, ts_hi = 0, nts = 0; const unsigned long long rt_entry = STAMP ? (unsigned long long)wall_clock64() : 0ull;
#define PG8_STAMP() do { if (STAMP && wid == 0 && nts < 64) { const unsigned long long _c = (unsigned long long)clock64(); \
        ts_lo = (lane == nts) ? (int)(unsigned)_c : ts_lo; ts_hi = (lane == nts) ? (int)(unsigned)(_c >> 32) : ts_hi; ++nts; } } while (0)
    PG8_STAMP();
    unsigned voffA[2], voffB[2];
#pragma unroll
    for (int i = 0; i < 2; ++i) { int R, C; stage_rc(tid * 16 + i * 8192, R, C); const int Rb = Epi::PERM ? ((R & ~31) + perm32(R & 31)) : R;
        voffA[i] = (unsigned)(R * g.lda + C) * 2u; voffB[i] = (unsigned)(Rb * K + C) * 2u; }
    const size_t kstep = (size_t)(BK * 2);
    const size_t hstep = (size_t)HALF * K * 2;
    const size_t tstep = 2 * hstep; const size_t hstepA = (size_t)HALF * g.lda * 2, tstepA = 2 * hstepA;
    const unsigned ldsw = (unsigned)wid * 1024u;
    const int aoff = lds_byte(wr * 64 + fr, fq * 8), boff = lds_byte(wc * 32 + fr, fq * 8);
#define PG8_SA(b, h) (((b) * 2 + (h)) * HTB)
#define PG8_SB(b, h) ((4 + (b) * 2 + (h)) * HTB)
#define PG8_STAGE(bufoff, gbase, voff) do { _Pragma("unroll") for (int _i = 0; _i < 2; ++_i) \
        __builtin_amdgcn_global_load_lds((const unsigned*)((const char*)(gbase) + (voff)[_i]), (PG8_LAS unsigned*)(lds + (bufoff) + ldsw + _i * 8192), 16, 0, 0); } while (0)
#define PG8_LDA(dst, b, h) do { _Pragma("unroll") for (int m = 0; m < 4; ++m) _Pragma("unroll") for (int k = 0; k < 2; ++k) dst[m][k] = *(const PG8_LAS bf16x8*)(lds + PG8_SA(b, h) + aoff + m * 2048 + k * 1024); } while (0)
#define PG8_LDB(dst, b, h) do { _Pragma("unroll") for (int n = 0; n < 2; ++n) _Pragma("unroll") for (int k = 0; k < 2; ++k) dst[n][k] = *(const PG8_LAS bf16x8*)(lds + PG8_SB(b, h) + boff + n * 2048 + k * 1024); } while (0)
#define PG8_MMA(ai, bj, At, Bt) do { __builtin_amdgcn_s_setprio(1); _Pragma("unroll") for (int m = 0; m < 4; ++m) _Pragma("unroll") for (int n = 0; n < 2; ++n) _Pragma("unroll") for (int k = 0; k < 2; ++k) \
        acc[ai][bj][m][n] = __builtin_amdgcn_mfma_f32_16x16x32_bf16(Bt[n][k], At[m][k], acc[ai][bj][m][n], 0, 0, 0); __builtin_amdgcn_s_setprio(0); } while (0)
#define PG8_WAIT_V(n) asm volatile("s_waitcnt vmcnt(" #n ")" ::: "memory")
#define PG8_WAIT_L(n) asm volatile("s_waitcnt lgkmcnt(" #n ")" ::: "memory")
#define PG8_BAR __builtin_amdgcn_s_barrier()
#define PG8_SCHED __builtin_amdgcn_sched_barrier(0)
    Unit cur, nxt; int ui = 0;
    if (!S.next(0, cur)) return;
    f32x4 acc[2][2][4][2];
#pragma unroll
    for (int a = 0; a < 2; ++a)
#pragma unroll
        for (int b = 0; b < 2; ++b)
#pragma unroll
            for (int m = 0; m < 4; ++m)
#pragma unroll
                for (int n = 0; n < 2; ++n) acc[a][b][m][n] = (f32x4){0.f, 0.f, 0.f, 0.f};
    bf16x8 At[4][2], B0[2][2], B1[2][2];
    const char* cA = (const char*)g.A + (size_t)cur.pm * tstepA; const char* cB = (const char*)g.Bt + (size_t)cur.pn * tstep;
    S.a_ready(cur);
    PG8_STAGE(PG8_SB(0, 0), cB, voffB); PG8_STAGE(PG8_SA(0, 0), cA, voffA); PG8_STAGE(PG8_SB(0, 1), cB + hstep, voffB); PG8_STAGE(PG8_SA(0, 1), cA + hstepA, voffA);
    if (wr == 1) PG8_BAR;
    PG8_WAIT_V(4); PG8_BAR;
    PG8_STAGE(PG8_SB(1, 0), cB + kstep, voffB); PG8_STAGE(PG8_SA(1, 0), cA + kstep, voffA); PG8_STAGE(PG8_SB(1, 1), cB + hstep + kstep, voffB);
    PG8_WAIT_V(6); PG8_BAR;
    PG8_STAMP();
    typename Epi::State est;
    for (;;) {
        E.prefetch(cur, wr, wc, fr, fq, est);
        const bool has_next = S.next(ui + 1, nxt);
        const char* nA = has_next ? (const char*)g.A + (size_t)nxt.pm * tstepA : cA; const char* nB = has_next ? (const char*)g.Bt + (size_t)nxt.pn * tstep : cB;
        for (int t = 0; t < nt; t += 2) {
            const bool last = (t == nt - 2);
            const char* a1 = cA + (size_t)(t + 1) * kstep;
            const char* a2 = last ? nA : cA + (size_t)(t + 2) * kstep; const char* b2 = last ? nB : cB + (size_t)(t + 2) * kstep;
            const char* a3 = a2 + kstep; const char* b3 = b2 + kstep;
            if (last && has_next) S.a_ready(nxt);
            PG8_LDB(B0, 0, 0); PG8_SCHED; PG8_LDA(At, 0, 0); PG8_STAGE(PG8_SA(1, 1), a1 + hstepA, voffA);
            PG8_WAIT_L(8); PG8_BAR; PG8_WAIT_L(0); PG8_MMA(0, 0, At, B0); PG8_BAR; PG8_SCHED;
            PG8_LDB(B1, 0, 1); PG8_STAGE(PG8_SB(0, 0), b2, voffB);
            PG8_BAR; PG8_WAIT_L(0); PG8_MMA(0, 1, At, B1); PG8_BAR;
            PG8_LDA(At, 0, 1); PG8_STAGE(PG8_SA(0, 0), a2, voffA);
            PG8_BAR; PG8_WAIT_L(0); PG8_MMA(1, 0, At, B0); PG8_BAR; PG8_SCHED;
            PG8_STAGE(PG8_SB(0, 1), b2 + hstep, voffB);
            PG8_WAIT_V(6); PG8_BAR; PG8_MMA(1, 1, At, B1); PG8_BAR;
            PG8_LDB(B0, 1, 0); PG8_SCHED; PG8_LDA(At, 1, 0); PG8_STAGE(PG8_SA(0, 1), a2 + hstepA, voffA);
            PG8_WAIT_L(8); PG8_BAR; PG8_WAIT_L(0); PG8_MMA(0, 0, At, B0); PG8_BAR; PG8_SCHED;
            PG8_LDB(B1, 1, 1); PG8_STAGE(PG8_SB(1, 0), b3, voffB);
            PG8_BAR; PG8_WAIT_L(0); PG8_MMA(0, 1, At, B1); PG8_BAR;
            PG8_LDA(At, 1, 1); PG8_STAGE(PG8_SA(1, 0), a3, voffA);
            PG8_BAR; PG8_WAIT_L(0); PG8_MMA(1, 0, At, B0); PG8_BAR; PG8_SCHED;
            PG8_STAGE(PG8_SB(1, 1), b3 + hstep, voffB);
            PG8_WAIT_V(6); PG8_BAR; PG8_MMA(1, 1, At, B1); PG8_BAR;
        }
        PG8_STAMP();
        if constexpr (!Epi::AFTER_DRAIN) { E(acc, cur, wr, wc, fr, fq, est); S.done(cur); }
        PG8_STAMP();
        if (!has_next) break;
#pragma unroll
        for (int a = 0; a < 2; ++a)
#pragma unroll
            for (int b = 0; b < 2; ++b)
#pragma unroll
                for (int m = 0; m < 4; ++m)
#pragma unroll
                    for (int n = 0; n < 2; ++n) acc[a][b][m][n] = (f32x4){0.f, 0.f, 0.f, 0.f};
        cur = nxt; cA = nA; cB = nB; ++ui;
    }
    PG8_WAIT_V(0);
    if (wr == 0) PG8_BAR;
    PG8_BAR;
    if constexpr (Epi::AFTER_DRAIN) { E.fused(acc, cur, wr, wc, fr, fq, lds, wid, lane); S.done(cur); }
    PG8_STAMP();
    if (STAMP && wid == 0) { stamps[lane] = lane < nts ? (((unsigned long long)(unsigned)ts_hi << 32) | (unsigned)ts_lo) : 0ull;
        if (lane == 62) stamps[62] = rt_entry; if (lane == 63) stamps[63] = (unsigned long long)wall_clock64(); }
#undef PG8_STAMP
#undef PG8_SA
#undef PG8_SB
#undef PG8_STAGE
#undef PG8_LDA
#undef PG8_LDB
#undef PG8_MMA
#undef PG8_WAIT_V
#undef PG8_WAIT_L
#undef PG8_BAR
#undef PG8_SCHED
}
}
#define XB_TMO      128
#define XB_XCNT(j)  (256  + 64 * (j))
#define XB_XSUB(j)  (1280 + 64 * (j))
#define XB_XGEN(j)  (2304 + 64 * (j))
#define XB_TOP      3328
#define XB_TOPGEN   3392
#define XCD_BAR_WORDS 3456
#define XB_SPIN_CAP (1u << 18)
#define XLAS __attribute__((address_space(3)))

__device__ __forceinline__ unsigned xb_ld(unsigned* p)              { return __hip_atomic_load(p, __ATOMIC_RELAXED, __HIP_MEMORY_SCOPE_AGENT); }
__device__ __forceinline__ unsigned xb_add(unsigned* p, unsigned v) { return __hip_atomic_fetch_add(p, v, __ATOMIC_RELAXED, __HIP_MEMORY_SCOPE_AGENT); }
__device__ __forceinline__ unsigned xb_xcc_id() { return (unsigned)__builtin_amdgcn_s_getreg((3 << 11) | 20) & 0xFu; }
#define XB_SPIN(cond, bar) do { unsigned _sp = 0; while (cond) { __builtin_amdgcn_s_sleep(1); \
    if ((++_sp & 255u) == 0u) { if (xb_ld(&(bar)[XB_TMO])) break; if (_sp > XB_SPIN_CAP) { atomicAdd(&(bar)[XB_TMO], 1u); break; } } } } while (0)

struct XcdBarrier {
    unsigned* bar; unsigned x;
    volatile XLAS unsigned* st;
};

__device__ __forceinline__ XcdBarrier xcd_barrier_post(unsigned* bar, volatile XLAS unsigned* st) {
    XcdBarrier b; b.bar = bar; b.x = xb_xcc_id(); b.st = st;
    if (threadIdx.x == 0) { const unsigned rank = xb_add(&bar[XB_XCNT(b.x)], 1u); st[3] = rank; }
    return b;
}
__device__ __forceinline__ void xcd_barrier_complete(unsigned* bar, unsigned x, unsigned& nloc, unsigned& nx) {
    const unsigned G = gridDim.x * gridDim.y * gridDim.z;
    unsigned sum, cnt, mine, sp = 0u;
    for (;;) {
        sum = 0u; cnt = 0u; mine = 0u;
#pragma unroll
        for (unsigned j = 0; j < 16; ++j) { const unsigned c = xb_ld(&bar[XB_XCNT(j)]); sum += c; cnt += (c > 0u) ? 1u : 0u; mine = (j == x) ? c : mine; }
        if (sum == G) break;
        __builtin_amdgcn_s_sleep(1);
        if ((++sp & 255u) == 0u) { if (xb_ld(&bar[XB_TMO])) break; if (sp > XB_SPIN_CAP) { atomicAdd(&bar[XB_TMO], 1u); break; } }
    }
    nloc = mine > 0u ? mine : 1u; nx = cnt > 0u ? cnt : 1u;
}

__device__ __forceinline__ void xcd_barrier(const XcdBarrier& b) {
    asm volatile("s_waitcnt vmcnt(0)" ::: "memory");
    __syncthreads();
    if (threadIdx.x == 0) {
        unsigned* bar = b.bar;
        __builtin_amdgcn_s_waitcnt(0);
        unsigned nloc = b.st[0], nx = b.st[1];
        if (nloc == 0u) { xcd_barrier_complete(bar, b.x, nloc, nx); b.st[0] = nloc; b.st[1] = nx; }
        const unsigned old = xb_add(&bar[XB_XSUB(b.x)], 1u);
        const unsigned gen = old / nloc;
        if (old + 1u == (gen + 1u) * nloc) {
            __builtin_amdgcn_fence(__ATOMIC_RELEASE, "agent");
            asm volatile("s_waitcnt vmcnt(0)" ::: "memory");
            const unsigned og = xb_add(&bar[XB_TOP], 1u);
            const unsigned tg = og / nx;
            if (og + 1u == (tg + 1u) * nx) xb_add(&bar[XB_TOPGEN], 1u);
            else XB_SPIN(xb_ld(&bar[XB_TOPGEN]) == tg, bar);
            __builtin_amdgcn_fence(__ATOMIC_ACQUIRE, "agent");
            xb_add(&bar[XB_XGEN(b.x)], 1u);
            asm volatile("s_waitcnt vmcnt(0)" ::: "memory");
        } else {
            XB_SPIN(xb_ld(&bar[XB_XGEN(b.x)]) == gen, bar);
            __builtin_amdgcn_fence(__ATOMIC_ACQUIRE, "agent");
            asm volatile("s_waitcnt vmcnt(0)" ::: "memory");
        }
    }
    __syncthreads();
}

using pg8::bf16_t; using pg8::bf16x8; using pg8::f32x4; using pg8::u32x4;
typedef float f32x16 __attribute__((ext_vector_type(16)));
typedef short s16x4 __attribute__((ext_vector_type(4)));
typedef unsigned u32x2 __attribute__((ext_vector_type(2)));

constexpr int NTOK = 49152, DM = 2048, NQKV = 6144, DFF = 5632, LP = 16384, LS = 4096, DEPTH = 2;
constexpr float EPS = 1e-6f;
constexpr float SCALE = 0.08838834764831845f;
constexpr int LDS_BYTES = pg8::STAGE_BYTES + 8192;
constexpr size_t E_WIN = (size_t)NQKV * DM, E_WOUT = (size_t)DM * DM, E_WGU = (size_t)2 * DFF * DM, E_WDN = (size_t)DM * DFF;
constexpr size_t OFF_WIN = 0, OFF_WOUT = OFF_WIN + 2 * E_WIN, OFF_WGU = OFF_WOUT + 2 * E_WOUT, OFF_WDN = OFF_WGU + 2 * E_WGU, WT_LAYER = OFF_WDN + 2 * E_WDN, OFF_QKV = DEPTH * WT_LAYER;
constexpr size_t OFF_H = OFF_QKV + (size_t)NTOK * NQKV * 2, OFF_LSE = OFF_H + (size_t)NTOK * DM * 2, OFF_BAR = OFF_LSE + (size_t)3 * NTOK * 8 * 4, OFF_RSA = OFF_BAR + 16384, OFF_RSF = OFF_RSA + (size_t)NTOK * 8, WS_END = OFF_RSF + (size_t)NTOK * 8;

typedef unsigned long long u64;
constexpr float RS_FIX = 1048576.0f, RS_INV = 1.0f / 1048576.0f;
__device__ __forceinline__ float rs_rstd(u64 v) { return 1.0f / sqrtf((float)v * (RS_INV / DM) + EPS); }
#ifndef MK_NCHUNK
#define MK_NCHUNK 2
#endif
constexpr int NCHUNK = MK_NCHUNK;
__device__ __forceinline__ int chunk_t0(int c) { return NCHUNK == 3 ? c * 16384 : (c ? 16384 : 0); }
__device__ __forceinline__ int chunk_m(int c) { return NCHUNK == 3 ? 16384 : (c ? 32768 : 16384); }
__device__ __forceinline__ int chunk_of(int tok) { return NCHUNK == 3 ? tok >> 14 : (tok >= 16384 ? 1 : 0); }
struct Params {
    const float *xp, *xs, *w_in, *w_out, *g_attn, *g_na, *g_dil, *rpb, *t5, *g_ffn, *w_gate, *w_up, *w_down, *g_final;
    float* out; unsigned char* ws;
};

__device__ __forceinline__ unsigned pk2(float lo, float hi) { unsigned r; asm volatile("v_cvt_pk_bf16_f32 %0, %1, %2" : "=v"(r) : "v"(lo), "v"(hi)); return r; }
__device__ __forceinline__ float wave_sum(float v) {
#pragma unroll
    for (int o = 1; o < 64; o <<= 1) v += __shfl_xor(v, o);
    return v;
}
__device__ __forceinline__ const float* xrow(const Params& p, int layer, int row) {
    if (layer) return p.out + (size_t)row * DM;
    return row < LP ? p.xp + (size_t)row * DM : p.xs + (size_t)(row - LP) * DM;
}

__device__ __forceinline__ void transpose_item(const float* W, int K, int N, bf16_t* WT, int k0, int n0, int dst_row0, float* scr, int lane, const float* gk) {
    float wv[32];
#pragma unroll
    for (int i = 0; i < 32; ++i) { const int kk = 2 * i + (lane >> 5); wv[i] = W[(size_t)(k0 + kk) * N + n0 + (lane & 31)]; }
    if (gk) {
#pragma unroll
        for (int i = 0; i < 32; ++i) wv[i] *= gk[k0 + 2 * i + (lane >> 5)]; }
#pragma unroll
    for (int i = 0; i < 32; ++i) scr[(2 * i + (lane >> 5)) * 33 + (lane & 31)] = wv[i];
    asm volatile("s_waitcnt lgkmcnt(0)" ::: "memory");
    const int c = lane & 7;
#pragma unroll
    for (int j = 0; j < 4; ++j) { const int n = (lane >> 3) + 8 * j; const float* s = scr + (8 * c) * 33 + n;
        u32x4 o; o.x = pk2(s[0 * 33], s[1 * 33]); o.y = pk2(s[2 * 33], s[3 * 33]); o.z = pk2(s[4 * 33], s[5 * 33]); o.w = pk2(s[6 * 33], s[7 * 33]);
        *(u32x4*)(WT + (size_t)(dst_row0 + n) * K + k0 + 8 * c) = o; }
    asm volatile("s_waitcnt lgkmcnt(0)" ::: "memory");
}
__device__ __forceinline__ void phase_weights(const Params& p, int layer, char* lds, int gw, int ngw, int wid, int lane) {
    float* scr = (float*)(lds + wid * 8448);
    constexpr int I_IN = 32 * 192, I_OUT = 32 * 64, I_G = 32 * 176, I_D = 88 * 64, NIT = I_IN + I_OUT + 2 * I_G + I_D;
    unsigned char* wl = p.ws + (size_t)layer * WT_LAYER;
    bf16_t* wt_in = (bf16_t*)(wl + OFF_WIN); bf16_t* wt_out = (bf16_t*)(wl + OFF_WOUT); bf16_t* wt_gu = (bf16_t*)(wl + OFF_WGU); bf16_t* wt_dn = (bf16_t*)(wl + OFF_WDN);
    for (int it = gw; it < NIT; it += ngw) {
        int r = it;
        if (r < I_IN) { const int kb = r / 192, nb = r % 192; transpose_item(p.w_in + (size_t)layer * DM * NQKV, DM, NQKV, wt_in, 64 * kb, 32 * nb, 32 * nb, scr, lane, p.g_attn + layer * DM); continue; } r -= I_IN;
        if (r < I_OUT) { const int kb = r / 64, nb = r % 64; transpose_item(p.w_out + (size_t)layer * DM * DM, DM, DM, wt_out, 64 * kb, 32 * nb, 32 * nb, scr, lane, nullptr); continue; } r -= I_OUT;
        if (r < 2 * I_G) { const int up = r >= I_G; if (up) r -= I_G; const int kb = r / 176, nb = r % 176, n0 = 32 * nb;
            transpose_item((up ? p.w_up : p.w_gate) + (size_t)layer * DM * DFF, DM, DFF, wt_gu, 64 * kb, n0, (n0 >> 7) * 256 + (n0 & 127) + (up ? 128 : 0), scr, lane, p.g_ffn + layer * DM); continue; } r -= 2 * I_G;
        { const int kb = r / 64, nb = r % 64; transpose_item(p.w_down + (size_t)layer * DFF * DM, DFF, DM, wt_dn, 64 * kb, 32 * nb, 32 * nb, scr, lane, nullptr); }
    }
}
__device__ __forceinline__ void phase_cvt(const Params& p, int gw, int ngw, int lane) {
    bf16_t* H = (bf16_t*)(p.ws + OFF_H); u64* rsa = (u64*)(p.ws + OFF_RSA);
    for (int row = gw; row < NTOK; row += ngw) {
        const f32x4* xr = (const f32x4*)xrow(p, 0, row) + lane;
        f32x4 v[8]; float s = 0.f;
#pragma unroll
        for (int j = 0; j < 8; ++j) { v[j] = xr[64 * j]; s += (v[j].x * v[j].x + v[j].y * v[j].y) + (v[j].z * v[j].z + v[j].w * v[j].w); }
        u32x2* o = (u32x2*)(H + (size_t)row * DM) + lane;
#pragma unroll
        for (int j = 0; j < 8; ++j) { u32x2 w; w.x = pk2(v[j].x, v[j].y); w.y = pk2(v[j].z, v[j].w); o[64 * j] = w; }
        s = wave_sum(s);
        if (lane == 0) rsa[row] = (u64)(s * RS_FIX);
    }
}
__device__ __forceinline__ float bf_lo(unsigned w);
__device__ __forceinline__ float bf_hi(unsigned w);
__device__ __forceinline__ void phase_final(const Params& p, int r0, int r1, int gw, int ngw, int lane) {
    const f32x4* gr = (const f32x4*)p.g_final + 2 * lane; const u64* rsa = (const u64*)(p.ws + OFF_RSA);
    for (int row = r0 + gw; row < r1; row += ngw) {
        const u32x4* xr = (const u32x4*)(p.ws + OFF_H + (size_t)row * 4096) + lane;
        u32x4 v[4];
#pragma unroll
        for (int j = 0; j < 4; ++j) v[j] = xr[64 * j];
        const float rstd = rs_rstd(rsa[row]);
        f32x4* o = (f32x4*)(p.out + (size_t)row * DM) + 2 * lane;
#pragma unroll
        for (int j = 0; j < 4; ++j) { const f32x4 g0 = gr[128 * j], g1 = gr[128 * j + 1];
            o[128 * j] = (f32x4){bf_lo(v[j].x) * rstd * g0.x, bf_hi(v[j].x) * rstd * g0.y, bf_lo(v[j].y) * rstd * g0.z, bf_hi(v[j].y) * rstd * g0.w};
            o[128 * j + 1] = (f32x4){bf_lo(v[j].z) * rstd * g1.x, bf_hi(v[j].z) * rstd * g1.y, bf_lo(v[j].w) * rstd * g1.z, bf_hi(v[j].w) * rstd * g1.w}; }
    }
}
__device__ __forceinline__ float bf_lo(unsigned w) { return __uint_as_float(w << 16); }
__device__ __forceinline__ float bf_hi(unsigned w) { return __uint_as_float(w & 0xffff0000u); }
__device__ __forceinline__ void unpack8(const u32x4 a, float* v) { v[0] = bf_lo(a.x); v[1] = bf_hi(a.x); v[2] = bf_lo(a.y); v[3] = bf_hi(a.y); v[4] = bf_lo(a.z); v[5] = bf_hi(a.z); v[6] = bf_lo(a.w); v[7] = bf_hi(a.w); }
__device__ __forceinline__ void phase_mixnorm(const Params& p, int layer, int r0, int r1, int gw, int ngw, int lane) {
    bf16_t* qkv = (bf16_t*)(p.ws + OFF_QKV); u64* rsa = (u64*)(p.ws + OFF_RSA); u64* rsf = (u64*)(p.ws + OFF_RSF);
    const float* lse = (const float*)(p.ws + OFF_LSE);
    const f32x4* ga = (const f32x4*)(p.g_na + layer * 1024) + 4 * lane; const f32x4* gd = (const f32x4*)(p.g_dil + layer * 1024) + 4 * lane;
    for (int row = r0 + gw; row < r1; row += ngw) {
        bf16_t* qrow = qkv + (size_t)row * NQKV;
        const u32x4* pa = (const u32x4*)qrow + 2 * lane;
        const int c = chunk_of(row); const size_t ct0 = (size_t)chunk_t0(c), cm = (size_t)chunk_m(c), rl = ((size_t)row - ct0) * 2048;
        const unsigned char* b0p = layer ? p.ws + OFF_H + ct0 * 4096 : (const unsigned char*)p.out + ct0 * 8192; const unsigned char* b1p = layer ? p.ws + OFF_H + ct0 * 4096 + cm * 2048 : (const unsigned char*)p.out + ct0 * 8192 + cm * 6144;
        const u32x4* p0 = (const u32x4*)(b0p + rl) + 2 * lane; const u32x4* p1 = (const u32x4*)(b1p + rl) + 2 * lane;
        const u32x4* p2 = (const u32x4*)((const unsigned char*)p.out + ct0 * 8192 + cm * 4096 + rl) + 2 * lane;
        const u32x4 a0 = pa[0], a1 = pa[1], b00 = p0[0], b01 = p0[1], b10 = p1[0], b11 = p1[1], b20 = p2[0], b21 = p2[1];
        const size_t li = (size_t)row * 8 + (lane >> 3);
        const float l0 = lse[li], l1 = lse[(size_t)NTOK * 8 + li], l2 = lse[(size_t)2 * NTOK * 8 + li];
        const float mx = fmaxf(l0, fmaxf(l1, l2)); float w0 = __expf(l0 - mx), w1 = __expf(l1 - mx), w2 = __expf(l2 - mx); const float wi = 1.0f / (w0 + w1 + w2); w0 *= wi; w1 *= wi; w2 *= wi;
        float av[16], bv[16], t1[16], t2[16];
        unpack8(a0, av); unpack8(a1, av + 8); unpack8(b00, bv); unpack8(b01, bv + 8); unpack8(b10, t1); unpack8(b11, t1 + 8); unpack8(b20, t2); unpack8(b21, t2 + 8);
        float sa = 0.f, sb = 0.f;
#pragma unroll
        for (int j = 0; j < 16; ++j) { bv[j] = bv[j] * w0 + t1[j] * w1 + t2[j] * w2; sa += av[j] * av[j]; sb += bv[j] * bv[j]; }
        const float ra = 1.0f / sqrtf(wave_sum(sa) * (1.0f / 1024) + EPS), rb = 1.0f / sqrtf(wave_sum(sb) * (1.0f / 1024) + EPS);
        if (lane == 0) { rsa[row] = 0ull; rsf[row] = 0ull; }
        u32x4 wa[2], wb[2];
#pragma unroll
        for (int q = 0; q < 2; ++q) { const f32x4 g0 = ga[2 * q], g1 = ga[2 * q + 1], h0 = gd[2 * q], h1 = gd[2 * q + 1]; const float* a = av + 8 * q; const float* b = bv + 8 * q;
            wa[q].x = pk2(a[0] * ra * g0.x, a[1] * ra * g0.y); wa[q].y = pk2(a[2] * ra * g0.z, a[3] * ra * g0.w); wa[q].z = pk2(a[4] * ra * g1.x, a[5] * ra * g1.y); wa[q].w = pk2(a[6] * ra * g1.z, a[7] * ra * g1.w);
            wb[q].x = pk2(b[0] * rb * h0.x, b[1] * rb * h0.y); wb[q].y = pk2(b[2] * rb * h0.z, b[3] * rb * h0.w); wb[q].z = pk2(b[4] * rb * h1.x, b[5] * rb * h1.y); wb[q].w = pk2(b[6] * rb * h1.z, b[7] * rb * h1.w); }
        u32x4* m0 = (u32x4*)(qrow + 1024) + 2 * lane; u32x4* m1 = (u32x4*)(qrow + 2048) + 2 * lane;
        m0[0] = wa[0]; m0[1] = wa[1]; m1[0] = wb[0]; m1[1] = wb[1];
    }
}

struct EpiBf16Scale {
    static constexpr bool PERM = true, AFTER_DRAIN = false;
    bf16_t* O; int ldc; const u64* rowss;
    struct State { u64 v[2][4]; };
    __device__ __forceinline__ void prefetch(const pg8::Unit& u, int wr, int wc, int fr, int fq, State& s) const {
        const int row0 = u.pm * 256 + wr * 64 + fr;
#pragma unroll
        for (int ai = 0; ai < 2; ++ai)
#pragma unroll
            for (int m = 0; m < 4; ++m) s.v[ai][m] = *(const __attribute__((address_space(1))) u64*)(rowss + row0 + ai * 128 + m * 16);
    }
    __device__ __forceinline__ void operator()(const f32x4 (&acc)[2][2][4][2], const pg8::Unit& u, int wr, int wc, int fr, int fq, const State& s) const {
        const int row0 = u.pm * 256 + wr * 64 + fr, col0 = u.pn * 256 + wc * 32 + 8 * fq;
#pragma unroll
        for (int ai = 0; ai < 2; ++ai)
#pragma unroll
            for (int m = 0; m < 4; ++m) { const int row = row0 + ai * 128 + m * 16; bf16_t* rowp = O + (size_t)row * ldc + col0;
                const float rs = rs_rstd(s.v[ai][m]);
#pragma unroll
                for (int bj = 0; bj < 2; ++bj) { const f32x4 v0 = acc[ai][bj][m][0] * rs, v1 = acc[ai][bj][m][1] * rs;
                    u32x4 w; w.x = pk2(v0[0], v0[1]); w.y = pk2(v0[2], v0[3]); w.z = pk2(v1[0], v1[1]); w.w = pk2(v1[2], v1[3]);
                    *(u32x4*)(rowp + bj * 128) = w; } }
    }
};
template <bool BASE_BF16> struct EpiResid {
    static constexpr bool PERM = true, AFTER_DRAIN = false;
    const float* base; const bf16_t* bsrc; float* out; bf16_t* xb; u64* rowss;
    struct State { u32x4 bb[2][2]; };
    __device__ __forceinline__ void prefetch(const pg8::Unit& u, int wr, int wc, int fr, int fq, State& s) const {
        const int row0 = u.pm * 256 + wr * 64 + fr, col0 = u.pn * 256 + wc * 32 + 8 * fq;
#pragma unroll
        for (int mm = 0; mm < 2; ++mm) { const size_t off = (size_t)(row0 + mm * 16) * DM + col0;
#pragma unroll
            for (int bj = 0; bj < 2; ++bj) { if (BASE_BF16) s.bb[mm][bj] = *(const __attribute__((address_space(1))) u32x4*)(bsrc + off + bj * 128); } }
    }
    __device__ __forceinline__ void operator()(const f32x4 (&acc)[2][2][4][2], const pg8::Unit& u, int wr, int wc, int fr, int fq, const State& s) const {
        const int row0 = u.pm * 256 + wr * 64 + fr, col0 = u.pn * 256 + wc * 32 + 8 * fq;
        f32x4 b[2][2][2][2];
        u32x4 bb[2][2][2];
#define EPI_LOADG(g, d, dd) do { _Pragma("unroll") for (int mm = 0; mm < 2; ++mm) { const size_t off = (size_t)(row0 + ((g) >> 1) * 128 + (((g) & 1) * 2 + mm) * 16) * DM + col0; \
        _Pragma("unroll") for (int bj = 0; bj < 2; ++bj) { if (BASE_BF16) dd[mm][bj] = *(const u32x4*)(bsrc + off + bj * 128); \
            else { d[mm][bj][0] = *(const f32x4*)(base + off + bj * 128); d[mm][bj][1] = *(const f32x4*)(base + off + bj * 128 + 4); } } } } while (0)
        if (BASE_BF16) {
#pragma unroll
            for (int mm = 0; mm < 2; ++mm)
#pragma unroll
                for (int bj = 0; bj < 2; ++bj) bb[0][mm][bj] = s.bb[mm][bj]; }
        else EPI_LOADG(0, b[0], bb[0]);
#pragma unroll
        for (int g = 0; g < 4; ++g) {
            if (g + 1 < 4) EPI_LOADG(g + 1, b[(g + 1) & 1], bb[(g + 1) & 1]);
            asm volatile("" ::: "memory");
#pragma unroll
            for (int mm = 0; mm < 2; ++mm) { const int ai = g >> 1, m = (g & 1) * 2 + mm, row = row0 + ai * 128 + m * 16; const size_t off = (size_t)row * DM + col0; float ss = 0.f;
#pragma unroll
                for (int bj = 0; bj < 2; ++bj) { f32x4 r0, r1;
                    if (BASE_BF16) { const u32x4 q = bb[g & 1][mm][bj]; r0 = (f32x4){bf_lo(q.x), bf_hi(q.x), bf_lo(q.y), bf_hi(q.y)}; r1 = (f32x4){bf_lo(q.z), bf_hi(q.z), bf_lo(q.w), bf_hi(q.w)}; }
                    else { r0 = b[g & 1][mm][bj][0]; r1 = b[g & 1][mm][bj][1]; }
                    const f32x4 v0 = r0 + acc[ai][bj][m][0], v1 = r1 + acc[ai][bj][m][1];
                    if (out) { *(f32x4*)(out + off + bj * 128) = v0; *(f32x4*)(out + off + bj * 128 + 4) = v1; }
                    u32x4 w; w.x = pk2(v0[0], v0[1]); w.y = pk2(v0[2], v0[3]); w.z = pk2(v1[0], v1[1]); w.w = pk2(v1[2], v1[3]); *(u32x4*)(xb + off + bj * 128) = w;
                    ss += ((v0[0] * v0[0] + v0[1] * v0[1]) + (v0[2] * v0[2] + v0[3] * v0[3])) + ((v1[0] * v1[0] + v1[1] * v1[1]) + (v1[2] * v1[2] + v1[3] * v1[3])); }
                ss += __shfl_xor(ss, 16); ss += __shfl_xor(ss, 32);
                if (fq == 0) (void)__hip_atomic_fetch_add(rowss + row, (u64)(ss * RS_FIX), __ATOMIC_RELAXED, __HIP_MEMORY_SCOPE_AGENT); }
            asm volatile("" ::: "memory");
        }
#undef EPI_LOADG
    }
};
__device__ __forceinline__ float silu_mul(float g, float u) { return g * u * __builtin_amdgcn_rcpf(1.0f + __builtin_amdgcn_exp2f(-1.4426950408889634f * g)); }
struct EpiSwiGLU {
    static constexpr bool PERM = true, AFTER_DRAIN = false;
    bf16_t* O; const u64* rowss;
    struct State { u64 v[2][4]; };
    __device__ __forceinline__ void prefetch(const pg8::Unit& u, int wr, int wc, int fr, int fq, State& s) const {
        const int row0 = u.pm * 256 + wr * 64 + fr;
#pragma unroll
        for (int ai = 0; ai < 2; ++ai)
#pragma unroll
            for (int m = 0; m < 4; ++m) s.v[ai][m] = *(const __attribute__((address_space(1))) u64*)(rowss + row0 + ai * 128 + m * 16);
    }
    __device__ __forceinline__ void operator()(const f32x4 (&acc)[2][2][4][2], const pg8::Unit& u, int wr, int wc, int fr, int fq, const State& s) const {
        const int row0 = u.pm * 256 + wr * 64 + fr, col0 = u.pn * 128 + wc * 32 + 8 * fq;
#pragma unroll
        for (int ai = 0; ai < 2; ++ai)
#pragma unroll
            for (int m = 0; m < 4; ++m) { const int row = row0 + ai * 128 + m * 16; bf16_t* rowp = O + (size_t)row * DFF + col0;
                const float rs = rs_rstd(s.v[ai][m]);
                const f32x4 g0 = acc[ai][0][m][0] * rs, g1 = acc[ai][0][m][1] * rs, u0 = acc[ai][1][m][0] * rs, u1 = acc[ai][1][m][1] * rs;
                u32x4 w; w.x = pk2(silu_mul(g0[0], u0[0]), silu_mul(g0[1], u0[1])); w.y = pk2(silu_mul(g0[2], u0[2]), silu_mul(g0[3], u0[3]));
                w.z = pk2(silu_mul(g1[0], u1[0]), silu_mul(g1[1], u1[1])); w.w = pk2(silu_mul(g1[2], u1[2]), silu_mul(g1[3], u1[3]));
                *(u32x4*)rowp = w; }
    }
};
#define KSWZ(row, colB) ((row) * 256 + ((colB) ^ (((row) & 7) << 4)))
#define SBAR() __builtin_amdgcn_sched_barrier(0)
__device__ __forceinline__ int crow(int r, int hi) { return (r & 3) + 8 * (r >> 2) + 4 * hi; }
__device__ __forceinline__ void qkt(f32x16& p0, f32x16& p1, const char* Ks, const bf16x8* qr, int r32, int hi) {
    p0 = f32x16{}; p1 = f32x16{};
#pragma unroll
    for (int d0 = 0; d0 < 8; ++d0) { const int cb = (d0 * 16 + hi * 8) * 2;
        const bf16x8 b0 = *reinterpret_cast<const bf16x8*>(Ks + KSWZ(r32, cb));
        const bf16x8 b1 = *reinterpret_cast<const bf16x8*>(Ks + KSWZ(32 + r32, cb));
        p0 = __builtin_amdgcn_mfma_f32_32x32x16_bf16(b0, qr[d0], p0, 0, 0, 0);
        p1 = __builtin_amdgcn_mfma_f32_32x32x16_bf16(b1, qr[d0], p1, 0, 0, 0); }
}
__device__ __forceinline__ int v_st(int k, int c) { const int kk = (k & ~0xC) | ((k & 4) << 1) | ((k & 8) >> 1); return ((kk >> 3) * 4 + (c >> 5)) * 512 + ((kk & 7) * 32 + (c & 31)) * 2; }
__device__ __forceinline__ int v_rd_base(int lane) { return ((lane & 3) << 3) | (((lane >> 2) & 3) << 6) | (((lane >> 4) & 1) << 5) | (((lane >> 5) & 1) << 8); }
constexpr int v_rd_off(int d0, int ks, int half) { return d0 * 512 + ks * 4096 + half * 2048; }
template <int OFF> __device__ __forceinline__ s16x4 tr_read(int vb) {
    s16x4 r; asm volatile("ds_read_b64_tr_b16 %0, %1 offset:%2" : "=&v"(r) : "v"(vb), "i"(OFF) : "memory"); return r;
}
#define PV_READ8(R, D0) do { R[0] = tr_read<v_rd_off(D0, 0, 0)>(vb); R[1] = tr_read<v_rd_off(D0, 0, 1)>(vb); R[2] = tr_read<v_rd_off(D0, 1, 0)>(vb); R[3] = tr_read<v_rd_off(D0, 1, 1)>(vb); \
    R[4] = tr_read<v_rd_off(D0, 2, 0)>(vb); R[5] = tr_read<v_rd_off(D0, 2, 1)>(vb); R[6] = tr_read<v_rd_off(D0, 3, 0)>(vb); R[7] = tr_read<v_rd_off(D0, 3, 1)>(vb); } while (0)
#define PV_PK(L, H) (bf16x8){L[0], L[1], L[2], L[3], H[0], H[1], H[2], H[3]}
#define PV_MMA4(OD, R) do { OD = __builtin_amdgcn_mfma_f32_32x32x16_bf16(pa0, PV_PK(R[0], R[1]), OD, 0, 0, 0); OD = __builtin_amdgcn_mfma_f32_32x32x16_bf16(pa1, PV_PK(R[2], R[3]), OD, 0, 0, 0); \
    OD = __builtin_amdgcn_mfma_f32_32x32x16_bf16(pa2, PV_PK(R[4], R[5]), OD, 0, 0, 0); OD = __builtin_amdgcn_mfma_f32_32x32x16_bf16(pa3, PV_PK(R[6], R[7]), OD, 0, 0, 0); } while (0)
__device__ __forceinline__ void pv_all(f32x16 (&o)[4], int vb, bf16x8 pa0, bf16x8 pa1, bf16x8 pa2, bf16x8 pa3) {
    s16x4 ra[8], rb[8];
    PV_READ8(ra, 0); PV_READ8(rb, 1);
    asm volatile("s_waitcnt lgkmcnt(8)" ::: "memory"); SBAR(); PV_MMA4(o[0], ra);
    PV_READ8(ra, 2);
    asm volatile("s_waitcnt lgkmcnt(8)" ::: "memory"); SBAR(); PV_MMA4(o[1], rb);
    PV_READ8(rb, 3);
    asm volatile("s_waitcnt lgkmcnt(8)" ::: "memory"); SBAR(); PV_MMA4(o[2], ra);
    asm volatile("s_waitcnt lgkmcnt(0)" ::: "memory"); SBAR(); PV_MMA4(o[3], rb);
}
#undef PV_READ8
#undef PV_PK
#undef PV_MMA4
__device__ __forceinline__ int t5_bucket(int rel) {
    const int n = rel < 0 ? -rel : rel;
    int b = n;
    if (n >= 8) { b = 5 + (31 - __builtin_clz(n)); if (b > 15) b = 15; }
    return b + (rel > 0 ? 16 : 0);
}

#define GAS __attribute__((address_space(1)))
__device__ __forceinline__ bf16_t* dil_buf(const Params& p, int c, int dsel, int layer) {
    const size_t ct0 = (size_t)chunk_t0(c), cm = (size_t)chunk_m(c);
    unsigned char* dsl = (unsigned char*)p.out + ct0 * 8192;
    if (dsel == 2) return (bf16_t*)(dsl + cm * 4096);
    if (layer == 0) return (bf16_t*)(dsel == 0 ? dsl : dsl + cm * 6144);
    return (bf16_t*)(p.ws + OFF_H + ct0 * 4096 + (size_t)dsel * cm * 2048);
}
template <bool NA>
__device__ __forceinline__ void attn_item(const Params& p, int layer, int dsel, int item, char* lds) {
    const int tid = ltid(), wid = __builtin_amdgcn_readfirstlane(tid >> 6), lane = tid & 63, r32 = lane & 31, hi = lane >> 5;
    bf16_t* qkv = (bf16_t*)(p.ws + OFF_QKV);
    float* wsf = (float*)(lds + 131072 + 256) + wid * 64; float* li_l = wsf; float* al_l = wsf + 32;
    float* T = (float*)(lds + 131072 + 256 + 2048);
    const float NINF = -__builtin_inff();
    const int h = item & 7, gb = item >> 3;
    int base, L, lb;
    if (gb < 64) { base = 0; L = LP; lb = gb; } else { const int s = (gb - 64) >> 4; lb = (gb - 64) & 15; base = LP + s * LS; L = LS; }
    const int dshift = NA ? 0 : 2 * dsel, d = 1 << dshift;
    const int nbr = (L >> 8) >> dshift;
    const int res = NA ? 0 : lb / nbr, b = NA ? lb : lb % nbr;
    const int q0 = b * 256, Lsub = L >> dshift;
    const int colq = (NA ? 0 : 3072) + h * 128, colk = colq + 1024, colv = colq + 2048;
    const int tok0 = base + res;
    int tlo, thi, kr0 = 0, rq = 0, off = wid >> 1;
    if (NA) { const int rows = L >> 6, r0 = 4 * lb; kr0 = min(max(r0 - 4, 0), rows - 8); const int kr3 = min(max(r0 + 3 - 4, 0), rows - 8); tlo = 0; thi = kr3 + 8 - kr0;
        rq = r0 + (wid >> 1); off = min(max(rq - 4, 0), rows - 8) - kr0; }
    else { tlo = (q0 == 0) ? 1 : 0; thi = (q0 + 256 == Lsub) ? 5 : 6; }
    const int S = NA ? 8 : 3;
    const int sr = tid >> 4, sc = (tid & 15) * 8, vst0 = v_st(sr, sc), vst1 = v_st(32 + sr, sc), kst0 = KSWZ(sr, sc * 2), kst1 = KSWZ(32 + sr, sc * 2);
#define KT(t) (NA ? (kr0 + (t)) * 64 : q0 - 64 + 64 * (t))
#define SLOAD(t, R) do { const bf16_t* r0p = qkv + (size_t)(tok0 + (KT(t) + sr) * d) * NQKV + sc; const bf16_t* r1p = r0p + (size_t)32 * d * NQKV; \
    R[0] = *(const GAS bf16x8*)(r0p + colk); R[1] = *(const GAS bf16x8*)(r1p + colk); R[2] = *(const GAS bf16x8*)(r0p + colv); R[3] = *(const GAS bf16x8*)(r1p + colv); } while (0)
#define SWRITE(bi, R) do { char* bb = lds + (bi) * 32768; *(bf16x8*)(bb + vst0) = R[2]; *(bf16x8*)(bb + vst1) = R[3]; *(bf16x8*)(bb + 16384 + kst0) = R[0]; *(bf16x8*)(bb + 16384 + kst1) = R[1]; } while (0)
    bf16x8 st[4][4];
#pragma unroll
    for (int i = 0; i < 4; ++i) if (i >= tlo && i < thi) SLOAD(i, st[i]);
    bf16x8 qr[8];
    { const bf16_t* Qw = qkv + (size_t)(tok0 + (q0 + wid * 32 + r32) * d) * NQKV + colq + hi * 8;
#pragma unroll
      for (int d0 = 0; d0 < 8; ++d0) qr[d0] = *(const GAS bf16x8*)(Qw + d0 * 16); }
    float tv0 = 0.f, tv1 = 0.f;
    if (NA) { const int i0 = tid - 48, i1 = tid + 512 - 48; if (i0 >= 0 && i0 < 465) tv0 = p.rpb[((size_t)layer * 465 + i0) * 8 + h] * (1.0f / SCALE); if (tid < 64 && i1 < 465) tv1 = p.rpb[((size_t)layer * 465 + i1) * 8 + h] * (1.0f / SCALE); }
    else { const int j = tid - 128; tv0 = (tid < 256 && j >= -64 && j <= 64) ? p.t5[t5_bucket(d * j) * 8 + h] * (1.0f / SCALE) : NINF; }
    __syncthreads();
    if (NA) { T[tid] = tv0; if (tid < 64) T[tid + 512] = tv1; } else { if (tid < 256) T[tid] = tv0; }
#pragma unroll
    for (int i = 0; i < 4; ++i) if (i >= tlo && i < thi) SWRITE(i, st[i]);
    const int cq = 32 * (wid & 1) + r32, clo = min(max(cq - 8, 0), 48);
    unsigned vmask = 0;
    if (NA) {
#pragma unroll
        for (int r = 0; r < 16; ++r) { const int ck = crow(r, hi); if ((unsigned)(ck - clo) < 16u) vmask |= 1u << r; if ((unsigned)(ck + 32 - clo) < 16u) vmask |= 1u << (16 + r); } }
    const int vrb = (int)(uintptr_t)lds + v_rd_base(lane);
    float m_reg = -1e30f, l_reg = 0.f; f32x16 o[4] = {};
    constexpr float C = SCALE * 1.4426950408889634f;
    for (int s = 0; s < S; ++s) {
        __syncthreads();
        const bool ld = (s + 1 < S) && (s + 4 < thi);
        if (ld) SLOAD(s + 4, st[0]);
        const int t = off + s;
        if (t >= tlo && t < thi) {
            const char* Kb = lds + (t & 3) * 32768 + 16384; const int vb0 = vrb + (t & 3) * 32768;
            f32x16 p0, p1;
            qkt(p0, p1, Kb, qr, r32, hi);
            if (NA) { const float* Tb = T + 48 + (kr0 + t - rq + 7) * 31 + 15 - cq + 4 * hi;
#pragma unroll
                for (int r = 0; r < 16; ++r) { const int oo = (r & 3) + 8 * (r >> 2); const float b0 = Tb[oo], b1 = Tb[oo + 32];
                    p0[r] = ((vmask >> r) & 1u) ? p0[r] + b0 : NINF; p1[r] = ((vmask >> (16 + r)) & 1u) ? p1[r] + b1 : NINF; } }
            else { const float* Tb = T + (KT(t) - (q0 + 32 * wid) - r32 + 128 + 4 * hi);
#pragma unroll
                for (int r = 0; r < 16; ++r) { const int oo = (r & 3) + 8 * (r >> 2); p0[r] += Tb[oo]; p1[r] += Tb[oo + 32]; } }
            float pmax = p0[0];
#pragma unroll
            for (int r = 1; r < 16; ++r) pmax = fmaxf(pmax, p0[r]);
#pragma unroll
            for (int r = 0; r < 16; ++r) pmax = fmaxf(pmax, p1[r]);
            { auto rr = __builtin_amdgcn_permlane32_swap(__float_as_uint(pmax), __float_as_uint(pmax), false, false);
              pmax = fmaxf(__uint_as_float(rr[0]), __uint_as_float(rr[1])); }
            float mn = m_reg, alpha = 1.f;
            if (!__all(pmax - m_reg <= 8.0f / SCALE)) { mn = fmaxf(m_reg, pmax); alpha = __builtin_amdgcn_exp2f((m_reg - mn) * C); m_reg = mn; }
            const float mnC = -mn * C;
            float ps = 0.f;
#pragma unroll
            for (int r = 0; r < 16; ++r) { p0[r] = __builtin_amdgcn_exp2f(fmaf(p0[r], C, mnC)); p1[r] = __builtin_amdgcn_exp2f(fmaf(p1[r], C, mnC)); ps += p0[r] + p1[r]; }
            { auto rr = __builtin_amdgcn_permlane32_swap(__float_as_uint(ps), __float_as_uint(ps), false, false);
              ps = __uint_as_float(rr[0]) + __uint_as_float(rr[1]); }
            l_reg = l_reg * alpha + ps;
            bf16x8 pa0, pa1, pa2, pa3;
#define PK4(P, BASE, OUT) do { unsigned a0 = pk2(P[BASE + 0], P[BASE + 1]), a1 = pk2(P[BASE + 2], P[BASE + 3]);   \
    unsigned b0 = pk2(P[BASE + 4], P[BASE + 5]), b1 = pk2(P[BASE + 6], P[BASE + 7]);                              \
    auto r0 = __builtin_amdgcn_permlane32_swap(a0, b0, false, false); auto r1 = __builtin_amdgcn_permlane32_swap(a1, b1, false, false); \
    u32x4 w = {r0[0], r1[0], r0[1], r1[1]}; OUT = *reinterpret_cast<bf16x8*>(&w); } while (0)
            PK4(p0, 0, pa0); PK4(p0, 8, pa1); PK4(p1, 0, pa2); PK4(p1, 8, pa3);
#undef PK4
            if (__any(alpha < 1.f)) { if (hi == 0) al_l[r32] = alpha; asm volatile("s_waitcnt lgkmcnt(0)" ::: "memory");
#pragma unroll
                for (int r = 0; r < 16; ++r) { const float a = al_l[crow(r, hi)];
#pragma unroll
                    for (int dd = 0; dd < 4; ++dd) o[dd][r] *= a; } }
            pv_all(o, vb0, pa0, pa1, pa2, pa3);
        }
        if (ld) { __syncthreads();
            SWRITE(s & 3, st[0]); }
    }
#undef SLOAD
#undef SWRITE
#undef KT
    if (hi == 0) li_l[r32] = l_reg; asm volatile("s_waitcnt lgkmcnt(0)" ::: "memory");
    bf16_t* Ob; int ldo;
    if (NA) { Ob = qkv + colq; ldo = NQKV; }
    else { const int c = chunk_of(base); Ob = dil_buf(p, c, dsel, layer) - (size_t)chunk_t0(c) * 1024 + h * 128; ldo = 1024; }
    if (!NA && hi == 0) { float* lse = (float*)(p.ws + OFF_LSE) + (size_t)dsel * NTOK * 8; lse[(size_t)(tok0 + (q0 + wid * 32 + r32) * d) * 8 + h] = m_reg * SCALE + __logf(l_reg); }
#pragma unroll
    for (int r = 0; r < 16; ++r) { const int orow = crow(r, hi); const float rl = __builtin_amdgcn_rcpf(li_l[orow]);
        bf16_t* op = Ob + (size_t)(tok0 + (q0 + wid * 32 + orow) * d) * ldo + r32;
#pragma unroll
        for (int dd = 0; dd < 4; ++dd) { const unsigned w = pk2(o[dd][r] * rl, 0.f); op[dd * 32] = (bf16_t)(w & 0xffffu); } }
}
template <class Epi>
__device__ __forceinline__ void run_gemm(char* lds, int M, const bf16_t* A, int lda, const bf16_t* Bt, int N, int K, const Epi& E) {
    pg8::Gemm g; g.A = A; g.Bt = Bt; g.M = M; g.N = N; g.K = K; g.lda = lda;
    pg8::StaticOrder S; S.init(M, N, lgdim(), lbid());
    pg8::gemm_phase<Epi, pg8::StaticOrder, false>((PG8_LAS unsigned char*)lds, g, S, E, nullptr);
}

template <class T> __device__ __forceinline__ T* launder(T* x) { asm volatile("" : "+s"(x)); return x; }
__device__ __forceinline__ void run_phase(const Params& p0, int layer, int ph, int chunk, char* shm) {
    Params p = p0;
    p.ws = launder(p.ws); p.out = launder(p.out);
    const int tid = ltid(), wid = __builtin_amdgcn_readfirstlane(tid >> 6), lane = tid & 63;
    const int G = lgdim(), bid = lbid(), gw = bid * 8 + wid, ngw = G * 8;
    const int t0 = chunk_t0(chunk), CM = chunk_m(chunk), nit = CM / 256 * 8, it0 = t0 / 256 * 8;
    bf16_t* qkv = (bf16_t*)(p.ws + OFF_QKV) + (size_t)t0 * NQKV; bf16_t* Hb = (bf16_t*)(p.ws + OFF_H) + (size_t)t0 * DM; unsigned char* wl = p.ws + (size_t)layer * WT_LAYER;
    u64* rsa = (u64*)(p.ws + OFF_RSA) + t0; u64* rsf = (u64*)(p.ws + OFF_RSF) + t0;
    bf16_t* xs2 = (bf16_t*)(p.out + (size_t)t0 * DM);
    switch (ph) {
    case 0: phase_weights(p, 0, shm, gw, ngw, wid, lane); phase_weights(p, 1, shm, gw, ngw, wid, lane); phase_cvt(p, gw, ngw, lane); break;
    case 1: { EpiBf16Scale E; E.O = qkv; E.ldc = NQKV; E.rowss = rsa; run_gemm(shm, CM, layer ? xs2 : Hb, DM, (bf16_t*)(wl + OFF_WIN), NQKV, DM, E); } break;
    case 2: for (int it = bid; it < 4 * nit; it += G) { if (it < nit) attn_item<true>(p, layer, 0, it0 + it, shm); else attn_item<false>(p, layer, (it - nit) / nit, it0 + (it - nit) % nit, shm); } break;
    case 6: phase_mixnorm(p, layer, t0, t0 + CM, gw, ngw, lane); break;
    case 7: { EpiResid<true> E; E.base = nullptr; E.bsrc = layer ? xs2 : Hb; E.out = nullptr; E.xb = Hb; E.rowss = rsf; run_gemm(shm, CM, qkv + 1024, NQKV, (bf16_t*)(wl + OFF_WOUT), DM, DM, E); } break;
    case 9: { EpiSwiGLU E; E.O = (bf16_t*)(p.ws + OFF_QKV) + (size_t)t0 * DFF; E.rowss = rsf; run_gemm(shm, CM, Hb, DM, (bf16_t*)(wl + OFF_WGU), 2 * DFF, DM, E); } break;
    case 10: { EpiResid<true> E; E.base = nullptr; E.bsrc = Hb; E.out = nullptr; E.xb = layer + 1 < DEPTH ? xs2 : Hb; E.rowss = rsa; run_gemm(shm, CM, (bf16_t*)(p.ws + OFF_QKV) + (size_t)t0 * DFF, DFF, (bf16_t*)(wl + OFF_WDN), DM, DFF, E); } break;
    default: phase_final(p, t0, t0 + CM, gw, ngw, lane); break;
    }
}
__global__ void __launch_bounds__(512) fwd_megakernel(Params p) {
    extern __shared__ __attribute__((aligned(16))) char shm[];
    cg::grid_group grid = cg::this_grid();
    volatile XLAS unsigned* st = (volatile XLAS unsigned*)(shm + pg8::STAGE_BYTES);
    if (threadIdx.x == 0) { st[0] = 0u; st[1] = 0u; st[2] = blockIdx.x; st[3] = 0u; }
    __syncthreads();
    const XcdBarrier xb = xcd_barrier_post((unsigned*)(p.ws + OFF_BAR), st);
    constexpr int PER_CHUNK = 6 * DEPTH + 1, NSTEP = 1 + NCHUNK * PER_CHUNK;
    for (int step = 0; step < NSTEP; ++step) {
        int layer = 0, ph = 0, chunk = 0;
        if (step > 0) { chunk = (step - 1) / PER_CHUNK; const int sc = (step - 1) % PER_CHUNK;
            if (sc == PER_CHUNK - 1) ph = 11; else { layer = sc / 6; const int s6 = sc % 6; ph = s6 < 2 ? s6 + 1 : (s6 == 2 ? 6 : (s6 == 3 ? 7 : s6 + 5)); } }
        run_phase(p, layer, ph, chunk, shm);
        if (step == 0) { grid.sync();
            if (threadIdx.x == 0) { unsigned* bar = (unsigned*)(p.ws + OFF_BAR); bool ok = (gridDim.x & 7u) == 0u;
                for (unsigned j = 0; j < 8; ++j) ok = ok && (xb_ld(&bar[XB_XCNT(j)]) == gridDim.x / 8u);
                if (ok) st[2] = st[3] * 8u + xb.x; }
            __syncthreads(); }
        else if (step + 1 < NSTEP) xcd_barrier(xb);
    }
}

extern "C" void kernel_launch(void* const* d_in, const int* in_sizes, int n_in, void* d_out, int out_size, void* d_ws, size_t ws_size, hipStream_t stream) {
    static int grid = 0;
    if (grid == 0) {
        if (n_in != 14 || ws_size < WS_END) { fprintf(stderr, "kernel_launch: need 14 inputs and %zu bytes of workspace, got %d / %zu\n", (size_t)WS_END, n_in, ws_size); grid = -1; return; }
        int dev = 0, cus = 0, per_cu = 0;
        if (hipGetDevice(&dev) != hipSuccess || hipDeviceGetAttribute(&cus, hipDeviceAttributeMultiprocessorCount, dev) != hipSuccess) { grid = -1; return; }
        if (hipFuncSetAttribute((const void*)fwd_megakernel, hipFuncAttributeMaxDynamicSharedMemorySize, LDS_BYTES) != hipSuccess) { fprintf(stderr, "kernel_launch: hipFuncSetAttribute failed\n"); grid = -1; return; }
        if (hipOccupancyMaxActiveBlocksPerMultiprocessor(&per_cu, (const void*)fwd_megakernel, 512, LDS_BYTES) != hipSuccess || per_cu < 1) { fprintf(stderr, "kernel_launch: occupancy query gave %d\n", per_cu); per_cu = 1; }
        (void)hipGetLastError();
        grid = cus;
    }
    if (grid < 0) return;
    Params p{};
    p.xp = (const float*)d_in[0]; p.xs = (const float*)d_in[1]; p.w_in = (const float*)d_in[2]; p.w_out = (const float*)d_in[3]; p.g_attn = (const float*)d_in[4];
    p.g_na = (const float*)d_in[5]; p.g_dil = (const float*)d_in[6]; p.rpb = (const float*)d_in[7]; p.t5 = (const float*)d_in[8]; p.g_ffn = (const float*)d_in[9];
    p.w_gate = (const float*)d_in[10]; p.w_up = (const float*)d_in[11]; p.w_down = (const float*)d_in[12]; p.g_final = (const float*)d_in[13];
    p.out = (float*)d_out; p.ws = (unsigned char*)d_ws;
    if (hipMemsetAsync((char*)d_ws + OFF_BAR, 0, 16384, stream) != hipSuccess) { fprintf(stderr, "kernel_launch: memset failed\n"); return; }
    void* args[] = {&p};
    hipError_t e = hipLaunchCooperativeKernel((const void*)fwd_megakernel, dim3(grid), dim3(512), args, LDS_BYTES, stream);
    if (e != hipSuccess) fprintf(stderr, "kernel_launch: cooperative launch failed: %s (grid %d)\n", hipGetErrorString(e), grid);
}
```

```cpp
#include <hip/hip_runtime.h>
#include <hip/hip_cooperative_groups.h>
#include <cstdio>
#include <cstdint>
#include <type_traits>
namespace cg = cooperative_groups;
__device__ __forceinline__ int ltid() { int t = threadIdx.x; asm volatile("" : "+v"(t)); return t; }
__device__ __forceinline__ int lbid() { extern __shared__ __attribute__((aligned(16))) char shm_dyn[]; int t = __builtin_amdgcn_readfirstlane(*(volatile int*)(shm_dyn + 131072 + 8)); asm volatile("" : "+s"(t)); return t; }
__device__ __forceinline__ int lgdim() { int t = gridDim.x; asm volatile("" : "+s"(t)); return t; }
namespace pg8 {
#define PG8_LAS __attribute__((address_space(3)))
typedef unsigned short bf16_t;
typedef short bf16x8 __attribute__((ext_vector_type(8)));
typedef float f32x4 __attribute__((ext_vector_type(4)));
typedef unsigned u32x4 __attribute__((ext_vector_type(4)));
constexpr int BM = 256, BK = 64, HALF = 128, HTB = HALF * BK * 2  , STAGE_BYTES = 8 * HTB, NXCD = 8, WGM = 4;

__host__ __device__ __forceinline__ int lds_byte(int r, int c) { const int st = (r >> 4) * 2 + (c >> 5), rr = r & 15, cc = c & 31, ob = rr * 64 + cc * 2; return st * 1024 + (ob ^ (((ob >> 9) & 1) << 5)); }
__host__ __device__ __forceinline__ void stage_rc(int b, int& R, int& C) { const int st = b / 1024, sb = b % 1024, swz = sb ^ (((sb >> 9) & 1) << 5); R = (st >> 1) * 16 + swz / 64; C = (st & 1) * 32 + (swz % 64) / 2; }
__host__ __device__ __forceinline__ int perm32(int rho) { const int n = rho >> 4, i = rho & 15; return 8 * (i >> 2) + 4 * n + (i & 3); }

struct Unit { int pm, pn; };
struct Gemm { const bf16_t* A; const bf16_t* Bt; int M, N, K, lda; };

struct StaticOrder {
    int nM, nN, nwg, G, c;
    __host__ __device__ void init(int M, int N, int G_, int c_) { nM = M / BM; nN = N / BM; nwg = nM * nN; G = G_; c = c_; }
    __host__ __device__ bool next(int i, Unit& u) const {
        const long L = (long)i * G + c; if (L >= nwg) return false;
        int wgid = (int)L; { const int q = nwg / NXCD, r = nwg % NXCD, xcd = wgid % NXCD, off = wgid / NXCD; wgid = (xcd < r ? xcd * (q + 1) : r * (q + 1) + (xcd - r) * q) + off; }
        const int nig = WGM * nN, gid = wgid / nig, fm = gid * WGM, gsz = (nM - fm) < WGM ? (nM - fm) : WGM;
        u.pm = fm + ((wgid % nig) % gsz); u.pn = (wgid % nig) / gsz; return true;
    }
    __device__ __forceinline__ void a_ready(const Unit&) const {}
    __device__ __forceinline__ void done(const Unit&) const {}
};
__device__ __forceinline__ unsigned cvt_pk_bf16(float lo, float hi) { unsigned r; asm volatile("v_cvt_pk_bf16_f32 %0, %1, %2" : "=v"(r) : "v"(lo), "v"(hi)); return r; }
template <class Epi, class Sched, bool STAMP = false>
__device__ __forceinline__ void gemm_phase(PG8_LAS unsigned char* lds, const Gemm g, const Sched& S, const Epi& E, unsigned long long* stamps) {
    const int tid = ltid(), wid = __builtin_amdgcn_readfirstlane(tid >> 6), lane = tid & 63, wr = wid >> 2, wc = wid & 3, fr = lane & 15, fq = lane >> 4;
    const int K = g.K, nt = K / BK;
    int ts_lo = 0, ts_hi = 0, nts = 0; const unsigned long long rt_entry = STAMP ? (unsigned long long)wall_clock64() : 0ull;
#define PG8_STAMP() do { if (STAMP && wid == 0 && nts < 64) { const unsigned long long _c = (unsigned long long)clock64(); \
        ts_lo = (lane == nts) ? (int)(unsigned)_c : ts_lo; ts_hi = (lane == nts) ? (int)(unsigned)(_c >> 32) : ts_hi; ++nts; } } while (0)
    PG8_STAMP();
    unsigned voffA[2], voffB[2];
#pragma unroll
    for (int i = 0; i < 2; ++i) { int R, C; stage_rc(tid * 16 + i * 8192, R, C); const int Rb = Epi::PERM ? ((R & ~31) + perm32(R & 31)) : R;
        voffA[i] = (unsigned)(R * g.lda + C) * 2u; voffB[i] = (unsigned)(Rb * K + C) * 2u; }
    const size_t kstep = (size_t)(BK * 2);
    const size_t hstep = (size_t)HALF * K * 2;
    const size_t tstep = 2 * hstep; const size_t hstepA = (size_t)HALF * g.lda * 2, tstepA = 2 * hstepA;
    const unsigned ldsw = (unsigned)wid * 1024u;
    const int aoff = lds_byte(wr * 64 + fr, fq * 8), boff = lds_byte(wc * 32 + fr, fq * 8);
#define PG8_SA(b, h) (((b) * 2 + (h)) * HTB)
#define PG8_SB(b, h) ((4 + (b) * 2 + (h)) * HTB)
#define PG8_STAGE(bufoff, gbase, voff) do { _Pragma("unroll") for (int _i = 0; _i < 2; ++_i) \
        __builtin_amdgcn_global_load_lds((const unsigned*)((const char*)(gbase) + (voff)[_i]), (PG8_LAS unsigned*)(lds + (bufoff) + ldsw + _i * 8192), 16, 0, 0); } while (0)
#define PG8_LDA(dst, b, h) do { _Pragma("unroll") for (int m = 0; m < 4; ++m) _Pragma("unroll") for (int k = 0; k < 2; ++k) dst[m][k] = *(const PG8_LAS bf16x8*)(lds + PG8_SA(b, h) + aoff + m * 2048 + k * 1024); } while (0)
#define PG8_LDB(dst, b, h) do { _Pragma("unroll") for (int n = 0; n < 2; ++n) _Pragma("unroll") for (int k = 0; k < 2; ++k) dst[n][k] = *(const PG8_LAS bf16x8*)(lds + PG8_SB(b, h) + boff + n * 2048 + k * 1024); } while (0)
#define PG8_MMA(ai, bj, At, Bt) do { __builtin_amdgcn_s_setprio(1); _Pragma("unroll") for (int m = 0; m < 4; ++m) _Pragma("unroll") for (int n = 0; n < 2; ++n) _Pragma("unroll") for (int k = 0; k < 2; ++k) \
        acc[ai][bj][m][n] = __builtin_amdgcn_mfma_f32_16x16x32_bf16(Bt[n][k], At[m][k], acc[ai][bj][m][n], 0, 0, 0); __builtin_amdgcn_s_setprio(0); } while (0)
#define PG8_WAIT_V(n) asm volatile("s_waitcnt vmcnt(" #n ")" ::: "memory")
#define PG8_WAIT_L(n) asm volatile("s_waitcnt lgkmcnt(" #n ")" ::: "memory")
#define PG8_BAR __builtin_amdgcn_s_barrier()
#define PG8_SCHED __builtin_amdgcn_sched_barrier(0)
    Unit cur, nxt; int ui = 0;
    if (!S.next(0, cur)) return;
    f32x4 acc[2][2][4][2];
#pragma unroll
    for (int a = 0; a < 2; ++a)
#pragma unroll
        for (int b = 0; b < 2; ++b)
#pragma unroll
            for (int m = 0; m < 4; ++m)
#pragma unroll
                for (int n = 0; n < 2; ++n) acc[a][b][m][n] = (f32x4){0.f, 0.f, 0.f, 0.f};
    bf16x8 At[4][2], B0[2][2], B1[2][2];
    const char* cA = (const char*)g.A + (size_t)cur.pm * tstepA; const char* cB = (const char*)g.Bt + (size_t)cur.pn * tstep;
    S.a_ready(cur);
    PG8_STAGE(PG8_SB(0, 0), cB, voffB); PG8_STAGE(PG8_SA(0, 0), cA, voffA); PG8_STAGE(PG8_SB(0, 1), cB + hstep, voffB); PG8_STAGE(PG8_SA(0, 1), cA + hstepA, voffA);
    if (wr == 1) PG8_BAR;
    PG8_WAIT_V(4); PG8_BAR;
    PG8_STAGE(PG8_SB(1, 0), cB + kstep, voffB); PG8_STAGE(PG8_SA(1, 0), cA + kstep, voffA); PG8_STAGE(PG8_SB(1, 1), cB + hstep + kstep, voffB);
    PG8_WAIT_V(6); PG8_BAR;
    PG8_STAMP();
    typename Epi::State est;
    for (;;) {
        E.prefetch(cur, wr, wc, fr, fq, est);
        const bool has_next = S.next(ui + 1, nxt);
        const char* nA = has_next ? (const char*)g.A + (size_t)nxt.pm * tstepA : cA; const char* nB = has_next ? (const char*)g.Bt + (size_t)nxt.pn * tstep : cB;
        for (int t = 0; t < nt; t += 2) {
            const bool last = (t == nt - 2);
            const char* a1 = cA + (size_t)(t + 1) * kstep;
            const char* a2 = last ? nA : cA + (size_t)(t + 2) * kstep; const char* b2 = last ? nB : cB + (size_t)(t + 2) * kstep;
            const char* a3 = a2 + kstep; const char* b3 = b2 + kstep;
            if (last && has_next) S.a_ready(nxt);
            PG8_LDB(B0, 0, 0); PG8_SCHED; PG8_LDA(At, 0, 0); PG8_STAGE(PG8_SA(1, 1), a1 + hstepA, voffA);
            PG8_WAIT_L(8); PG8_BAR; PG8_WAIT_L(0); PG8_MMA(0, 0, At, B0); PG8_BAR; PG8_SCHED;
            PG8_LDB(B1, 0, 1); PG8_STAGE(PG8_SB(0, 0), b2, voffB);
            PG8_BAR; PG8_WAIT_L(0); PG8_MMA(0, 1, At, B1); PG8_BAR;
            PG8_LDA(At, 0, 1); PG8_STAGE(PG8_SA(0, 0), a2, voffA);
            PG8_BAR; PG8_WAIT_L(0); PG8_MMA(1, 0, At, B0); PG8_BAR; PG8_SCHED;
            PG8_STAGE(PG8_SB(0, 1), b2 + hstep, voffB);
            PG8_WAIT_V(6); PG8_BAR; PG8_MMA(1, 1, At, B1); PG8_BAR;
            PG8_LDB(B0, 1, 0); PG8_SCHED; PG8_LDA(At, 1, 0); PG8_STAGE(PG8_SA(0, 1), a2 + hstepA, voffA);
            PG8_WAIT_L(8); PG8_BAR; PG8_WAIT_L(0); PG8_MMA(0, 0, At, B0); PG8_BAR; PG8_SCHED;
            PG8_LDB(B1, 1, 1); PG8_STAGE(PG8_SB(1, 0), b3, voffB);
            PG8_BAR; PG8_WAIT_L(0); PG8_MMA(0, 1, At, B1); PG8_BAR;
            PG8_LDA(At, 1, 1); PG8_STAGE(PG8_SA(1, 0), a3, voffA);
            PG8_BAR; PG8_WAIT_L(0); PG8_MMA(1, 0, At, B0); PG8_BAR; PG8_SCHED;
            PG8_STAGE(PG8_SB(1, 1), b3 + hstep, voffB);
            PG8_WAIT_V(6); PG8_BAR; PG8_MMA(1, 1, At, B1); PG8_BAR;
        }
        PG8_STAMP();
        if constexpr (!Epi::AFTER_DRAIN) { E(acc, cur, wr, wc, fr, fq, est); S.done(cur); }
        PG8_STAMP();
        if (!has_next) break;
#pragma unroll
        for (int a = 0; a < 2; ++a)
#pragma unroll
            for (int b = 0; b < 2; ++b)
#pragma unroll
                for (int m = 0; m < 4; ++m)
#pragma unroll
                    for (int n = 0; n < 2; ++n) acc[a][b][m][n] = (f32x4){0.f, 0.f, 0.f, 0.f};
        cur = nxt; cA = nA; cB = nB; ++ui;
    }
    PG8_WAIT_V(0);
    if (wr == 0) PG8_BAR;
    PG8_BAR;
    if constexpr (Epi::AFTER_DRAIN) { E.fused(acc, cur, wr, wc, fr, fq, lds, wid, lane); S.done(cur); }
    PG8_STAMP();
    if (STAMP && wid == 0) { stamps[lane] = lane < nts ? (((unsigned long long)(unsigned)ts_hi << 32) | (unsigned)ts_lo) : 0ull;
        if (lane == 62) stamps[62] = rt_entry; if (lane == 63) stamps[63] = (unsigned long long)wall_clock64(); }
#undef PG8_STAMP
#undef PG8_SA
#undef PG8_SB
#undef PG8_STAGE
#undef PG8_LDA
#undef PG8_LDB
#undef PG8_MMA
#undef PG8_WAIT_V
#undef PG8_WAIT_L
#undef PG8_BAR
#undef PG8_SCHED
}
}
#define XB_TMO      128
#define XB_XCNT(j)  (256  + 64 * (j))
#define XB_XSUB(j)  (1280 + 64 * (j))
#define XB_XGEN(j)  (2304 + 64 * (j))
#define XB_TOP      3328
#define XB_TOPGEN   3392
#define XCD_BAR_WORDS 3456
#define XB_SPIN_CAP (1u << 18)
#define XLAS __attribute__((address_space(3)))

__device__ __forceinline__ unsigned xb_ld(unsigned* p)              { return __hip_atomic_load(p, __ATOMIC_RELAXED, __HIP_MEMORY_SCOPE_AGENT); }
__device__ __forceinline__ unsigned xb_add(unsigned* p, unsigned v) { return __hip_atomic_fetch_add(p, v, __ATOMIC_RELAXED, __HIP_MEMORY_SCOPE_AGENT); }
__device__ __forceinline__ unsigned xb_xcc_id() { return (unsigned)__builtin_amdgcn_s_getreg((3 << 11) | 20) & 0xFu; }
#define XB_SPIN(cond, bar) do { unsigned _sp = 0; while (cond) { __builtin_amdgcn_s_sleep(1); \
    if ((++_sp & 255u) == 0u) { if (xb_ld(&(bar)[XB_TMO])) break; if (_sp > XB_SPIN_CAP) { atomicAdd(&(bar)[XB_TMO], 1u); break; } } } } while (0)

struct XcdBarrier {
    unsigned* bar; unsigned x;
    volatile XLAS unsigned* st;
};

__device__ __forceinline__ XcdBarrier xcd_barrier_post(unsigned* bar, volatile XLAS unsigned* st) {
    XcdBarrier b; b.bar = bar; b.x = xb_xcc_id(); b.st = st;
    if (threadIdx.x == 0) { const unsigned rank = xb_add(&bar[XB_XCNT(b.x)], 1u); st[3] = rank; }
    return b;
}
__device__ __forceinline__ void xcd_barrier_complete(unsigned* bar, unsigned x, unsigned& nloc, unsigned& nx) {
    const unsigned G = gridDim.x * gridDim.y * gridDim.z;
    unsigned sum, cnt, mine, sp = 0u;
    for (;;) {
        sum = 0u; cnt = 0u; mine = 0u;
#pragma unroll
        for (unsigned j = 0; j < 16; ++j) { const unsigned c = xb_ld(&bar[XB_XCNT(j)]); sum += c; cnt += (c > 0u) ? 1u : 0u; mine = (j == x) ? c : mine; }
        if (sum == G) break;
        __builtin_amdgcn_s_sleep(1);
        if ((++sp & 255u) == 0u) { if (xb_ld(&bar[XB_TMO])) break; if (sp > XB_SPIN_CAP) { atomicAdd(&bar[XB_TMO], 1u); break; } }
    }
    nloc = mine > 0u ? mine : 1u; nx = cnt > 0u ? cnt : 1u;
}

__device__ __forceinline__ void xcd_barrier(const XcdBarrier& b) {
    asm volatile("s_waitcnt vmcnt(0)" ::: "memory");
    __syncthreads();
    if (threadIdx.x == 0) {
        unsigned* bar = b.bar;
        __builtin_amdgcn_s_waitcnt(0);
        unsigned nloc = b.st[0], nx = b.st[1];
        if (nloc == 0u) { xcd_barrier_complete(bar, b.x, nloc, nx); b.st[0] = nloc; b.st[1] = nx; }
        const unsigned old = xb_add(&bar[XB_XSUB(b.x)], 1u);
        const unsigned gen = old / nloc;
        if (old + 1u == (gen + 1u) * nloc) {
            __builtin_amdgcn_fence(__ATOMIC_RELEASE, "agent");
            asm volatile("s_waitcnt vmcnt(0)" ::: "memory");
            const unsigned og = xb_add(&bar[XB_TOP], 1u);
            const unsigned tg = og / nx;
            if (og + 1u == (tg + 1u) * nx) xb_add(&bar[XB_TOPGEN], 1u);
            else XB_SPIN(xb_ld(&bar[XB_TOPGEN]) == tg, bar);
            __builtin_amdgcn_fence(__ATOMIC_ACQUIRE, "agent");
            xb_add(&bar[XB_XGEN(b.x)], 1u);
            asm volatile("s_waitcnt vmcnt(0)" ::: "memory");
        } else {
            XB_SPIN(xb_ld(&bar[XB_XGEN(b.x)]) == gen, bar);
            __builtin_amdgcn_fence(__ATOMIC_ACQUIRE, "agent");
            asm volatile("s_waitcnt vmcnt(0)" ::: "memory");
        }
    }
    __syncthreads();
}

using pg8::bf16_t; using pg8::bf16x8; using pg8::f32x4; using pg8::u32x4;
typedef float f32x16 __attribute__((ext_vector_type(16)));
typedef short s16x4 __attribute__((ext_vector_type(4)));
typedef unsigned u32x2 __attribute__((ext_vector_type(2)));

constexpr int NTOK = 49152, DM = 2048, NQKV = 6144, DFF = 5632, LP = 16384, LS = 4096, DEPTH = 2;
constexpr float EPS = 1e-6f;
constexpr float SCALE = 0.08838834764831845f;
constexpr int LDS_BYTES = pg8::STAGE_BYTES + 8192;
constexpr size_t E_WIN = (size_t)NQKV * DM, E_WOUT = (size_t)DM * DM, E_WGU = (size_t)2 * DFF * DM, E_WDN = (size_t)DM * DFF;
constexpr size_t OFF_WIN = 0, OFF_WOUT = OFF_WIN + 2 * E_WIN, OFF_WGU = OFF_WOUT + 2 * E_WOUT, OFF_WDN = OFF_WGU + 2 * E_WGU, WT_LAYER = OFF_WDN + 2 * E_WDN, OFF_QKV = DEPTH * WT_LAYER;
constexpr size_t OFF_H = OFF_QKV + (size_t)NTOK * NQKV * 2, OFF_LSE = OFF_H + (size_t)NTOK * DM * 2, OFF_BAR = OFF_LSE + (size_t)3 * NTOK * 8 * 4, OFF_RSA = OFF_BAR + 16384, OFF_RSF = OFF_RSA + (size_t)NTOK * 8, WS_END = OFF_RSF + (size_t)NTOK * 8;

typedef unsigned long long u64;
constexpr float RS_FIX = 1048576.0f, RS_INV = 1.0f / 1048576.0f;
__device__ __forceinline__ float rs_rstd(u64 v) { return 1.0f / sqrtf((float)v * (RS_INV / DM) + EPS); }
#ifndef MK_NCHUNK
#define MK_NCHUNK 2
#endif
constexpr int NCHUNK = MK_NCHUNK;
__device__ __forceinline__ int chunk_t0(int c) { return NCHUNK == 3 ? c * 16384 : (c ? 16384 : 0); }
__device__ __forceinline__ int chunk_m(int c) { return NCHUNK == 3 ? 16384 : (c ? 32768 : 16384); }
__device__ __forceinline__ int chunk_of(int tok) { return NCHUNK == 3 ? tok >> 14 : (tok >= 16384 ? 1 : 0); }
struct Params {
    const float *xp, *xs, *w_in, *w_out, *g_attn, *g_na, *g_dil, *rpb, *t5, *g_ffn, *w_gate, *w_up, *w_down, *g_final;
    float* out; unsigned char* ws;
};

__device__ __forceinline__ unsigned pk2(float lo, float hi) { unsigned r; asm volatile("v_cvt_pk_bf16_f32 %0, %1, %2" : "=v"(r) : "v"(lo), "v"(hi)); return r; }
__device__ __forceinline__ float wave_sum(float v) {
#pragma unroll
    for (int o = 1; o < 64; o <<= 1) v += __shfl_xor(v, o);
    return v;
}
__device__ __forceinline__ const float* xrow(const Params& p, int layer, int row) {
    if (layer) return p.out + (size_t)row * DM;
    return row < LP ? p.xp + (size_t)row * DM : p.xs + (size_t)(row - LP) * DM;
}

__device__ __forceinline__ void transpose_item(const float* W, int K, int N, bf16_t* WT, int k0, int n0, int dst_row0, float* scr, int lane, const float* gk) {
    float wv[32];
#pragma unroll
    for (int i = 0; i < 32; ++i) { const int kk = 2 * i + (lane >> 5); wv[i] = W[(size_t)(k0 + kk) * N + n0 + (lane & 31)]; }
    if (gk) {
#pragma unroll
        for (int i = 0; i < 32; ++i) wv[i] *= gk[k0 + 2 * i + (lane >> 5)]; }
#pragma unroll
    for (int i = 0; i < 32; ++i) scr[(2 * i + (lane >> 5)) * 33 + (lane & 31)] = wv[i];
    asm volatile("s_waitcnt lgkmcnt(0)" ::: "memory");
    const int c = lane & 7;
#pragma unroll
    for (int j = 0; j < 4; ++j) { const int n = (lane >> 3) + 8 * j; const float* s = scr + (8 * c) * 33 + n;
        u32x4 o; o.x = pk2(s[0 * 33], s[1 * 33]); o.y = pk2(s[2 * 33], s[3 * 33]); o.z = pk2(s[4 * 33], s[5 * 33]); o.w = pk2(s[6 * 33], s[7 * 33]);
        *(u32x4*)(WT + (size_t)(dst_row0 + n) * K + k0 + 8 * c) = o; }
    asm volatile("s_waitcnt lgkmcnt(0)" ::: "memory");
}
__device__ __forceinline__ void phase_weights(const Params& p, int layer, char* lds, int gw, int ngw, int wid, int lane) {
    float* scr = (float*)(lds + wid * 8448);
    constexpr int I_IN = 32 * 192, I_OUT = 32 * 64, I_G = 32 * 176, I_D = 88 * 64, NIT = I_IN + I_OUT + 2 * I_G + I_D;
    unsigned char* wl = p.ws + (size_t)layer * WT_LAYER;
    bf16_t* wt_in = (bf16_t*)(wl + OFF_WIN); bf16_t* wt_out = (bf16_t*)(wl + OFF_WOUT); bf16_t* wt_gu = (bf16_t*)(wl + OFF_WGU); bf16_t* wt_dn = (bf16_t*)(wl + OFF_WDN);
    for (int it = gw; it < NIT; it += ngw) {
        int r = it;
        if (r < I_IN) { const int kb = r / 192, nb = r % 192; transpose_item(p.w_in + (size_t)layer * DM * NQKV, DM, NQKV, wt_in, 64 * kb, 32 * nb, 32 * nb, scr, lane, p.g_attn + layer * DM); continue; } r -= I_IN;
        if (r < I_OUT) { const int kb = r / 64, nb = r % 64; transpose_item(p.w_out + (size_t)layer * DM * DM, DM, DM, wt_out, 64 * kb, 32 * nb, 32 * nb, scr, lane, nullptr); continue; } r -= I_OUT;
        if (r < 2 * I_G) { const int up = r >= I_G; if (up) r -= I_G; const int kb = r / 176, nb = r % 176, n0 = 32 * nb;
            transpose_item((up ? p.w_up : p.w_gate) + (size_t)layer * DM * DFF, DM, DFF, wt_gu, 64 * kb, n0, (n0 >> 7) * 256 + (n0 & 127) + (up ? 128 : 0), scr, lane, p.g_ffn + layer * DM); continue; } r -= 2 * I_G;
        { const int kb = r / 64, nb = r % 64; transpose_item(p.w_down + (size_t)layer * DFF * DM, DFF, DM, wt_dn, 64 * kb, 32 * nb, 32 * nb, scr, lane, nullptr); }
    }
}
__device__ __forceinline__ void phase_cvt(const Params& p, int gw, int ngw, int lane) {
    bf16_t* H = (bf16_t*)(p.ws + OFF_H); u64* rsa = (u64*)(p.ws + OFF_RSA);
    for (int row = gw; row < NTOK; row += ngw) {
        const f32x4* xr = (const f32x4*)xrow(p, 0, row) + lane;
        f32x4 v[8]; float s = 0.f;
#pragma unroll
        for (int j = 0; j < 8; ++j) { v[j] = xr[64 * j]; s += (v[j].x * v[j].x + v[j].y * v[j].y) + (v[j].z * v[j].z + v[j].w * v[j].w); }
        u32x2* o = (u32x2*)(H + (size_t)row * DM) + lane;
#pragma unroll
        for (int j = 0; j < 8; ++j) { u32x2 w; w.x = pk2(v[j].x, v[j].y); w.y = pk2(v[j].z, v[j].w); o[64 * j] = w; }
        s = wave_sum(s);
        if (lane == 0) rsa[row] = (u64)(s * RS_FIX);
    }
}
__device__ __forceinline__ float bf_lo(unsigned w);
__device__ __forceinline__ float bf_hi(unsigned w);
__device__ __forceinline__ void phase_final(const Params& p, int r0, int r1, int gw, int ngw, int lane) {
    const f32x4* gr = (const f32x4*)p.g_final + 2 * lane; const u64* rsa = (const u64*)(p.ws + OFF_RSA);
    for (int row = r0 + gw; row < r1; row += ngw) {
        const u32x4* xr = (const u32x4*)(p.ws + OFF_H + (size_t)row * 4096) + lane;
        u32x4 v[4];
#pragma unroll
        for (int j = 0; j < 4; ++j) v[j] = xr[64 * j];
        const float rstd = rs_rstd(rsa[row]);
        f32x4* o = (f32x4*)(p.out + (size_t)row * DM) + 2 * lane;
#pragma unroll
        for (int j = 0; j < 4; ++j) { const f32x4 g0 = gr[128 * j], g1 = gr[128 * j + 1];
            o[128 * j] = (f32x4){bf_lo(v[j].x) * rstd * g0.x, bf_hi(v[j].x) * rstd * g0.y, bf_lo(v[j].y) * rstd * g0.z, bf_hi(v[j].y) * rstd * g0.w};
            o[128 * j + 1] = (f32x4){bf_lo(v[j].z) * rstd * g1.x, bf_hi(v[j].z) * rstd * g1.y, bf_lo(v[j].w) * rstd * g1.z, bf_hi(v[j].w) * rstd * g1.w}; }
    }
}
__device__ __forceinline__ float bf_lo(unsigned w) { return __uint_as_float(w << 16); }
__device__ __forceinline__ float bf_hi(unsigned w) { return __uint_as_float(w & 0xffff0000u); }
__device__ __forceinline__ void unpack8(const u32x4 a, float* v) { v[0] = bf_lo(a.x); v[1] = bf_hi(a.x); v[2] = bf_lo(a.y); v[3] = bf_hi(a.y); v[4] = bf_lo(a.z); v[5] = bf_hi(a.z); v[6] = bf_lo(a.w); v[7] = bf_hi(a.w); }
__device__ __forceinline__ void phase_mixnorm(const Params& p, int layer, int r0, int r1, int gw, int ngw, int lane) {
    bf16_t* qkv = (bf16_t*)(p.ws + OFF_QKV); u64* rsa = (u64*)(p.ws + OFF_RSA); u64* rsf = (u64*)(p.ws + OFF_RSF);
    const float* lse = (const float*)(p.ws + OFF_LSE);
    const f32x4* ga = (const f32x4*)(p.g_na + layer * 1024) + 4 * lane; const f32x4* gd = (const f32x4*)(p.g_dil + layer * 1024) + 4 * lane;
    for (int row = r0 + gw; row < r1; row += ngw) {
        bf16_t* qrow = qkv + (size_t)row * NQKV;
        const u32x4* pa = (const u32x4*)qrow + 2 * lane;
        const int c = chunk_of(row); const size_t ct0 = (size_t)chunk_t0(c), cm = (size_t)chunk_m(c), rl = ((size_t)row - ct0) * 2048;
        const unsigned char* b0p = layer ? p.ws + OFF_H + ct0 * 4096 : (const unsigned char*)p.out + ct0 * 8192; const unsigned char* b1p = layer ? p.ws + OFF_H + ct0 * 4096 + cm * 2048 : (const unsigned char*)p.out + ct0 * 8192 + cm * 6144;
        const u32x4* p0 = (const u32x4*)(b0p + rl) + 2 * lane; const u32x4* p1 = (const u32x4*)(b1p + rl) + 2 * lane;
        const u32x4* p2 = (const u32x4*)((const unsigned char*)p.out + ct0 * 8192 + cm * 4096 + rl) + 2 * lane;
        const u32x4 a0 = pa[0], a1 = pa[1], b00 = p0[0], b01 = p0[1], b10 = p1[0], b11 = p1[1], b20 = p2[0], b21 = p2[1];
        const size_t li = (size_t)row * 8 + (lane >> 3);
        const float l0 = lse[li], l1 = lse[(size_t)NTOK * 8 + li], l2 = lse[(size_t)2 * NTOK * 8 + li];
        const float mx = fmaxf(l0, fmaxf(l1, l2)); float w0 = __expf(l0 - mx), w1 = __expf(l1 - mx), w2 = __expf(l2 - mx); const float wi = 1.0f / (w0 + w1 + w2); w0 *= wi; w1 *= wi; w2 *= wi;
        float av[16], bv[16], t1[16], t2[16];
        unpack8(a0, av); unpack8(a1, av + 8); unpack8(b00, bv); unpack8(b01, bv + 8); unpack8(b10, t1); unpack8(b11, t1 + 8); unpack8(b20, t2); unpack8(b21, t2 + 8);
        float sa = 0.f, sb = 0.f;
#pragma unroll
        for (int j = 0; j < 16; ++j) { bv[j] = bv[j] * w0 + t1[j] * w1 + t2[j] * w2; sa += av[j] * av[j]; sb += bv[j] * bv[j]; }
        const float ra = 1.0f / sqrtf(wave_sum(sa) * (1.0f / 1024) + EPS), rb = 1.0f / sqrtf(wave_sum(sb) * (1.0f / 1024) + EPS);
        if (lane == 0) { rsa[row] = 0ull; rsf[row] = 0ull; }
        u32x4 wa[2], wb[2];
#pragma unroll
        for (int q = 0; q < 2; ++q) { const f32x4 g0 = ga[2 * q], g1 = ga[2 * q + 1], h0 = gd[2 * q], h1 = gd[2 * q + 1]; const float* a = av + 8 * q; const float* b = bv + 8 * q;
            wa[q].x = pk2(a[0] * ra * g0.x, a[1] * ra * g0.y); wa[q].y = pk2(a[2] * ra * g0.z, a[3] * ra * g0.w); wa[q].z = pk2(a[4] * ra * g1.x, a[5] * ra * g1.y); wa[q].w = pk2(a[6] * ra * g1.z, a[7] * ra * g1.w);
            wb[q].x = pk2(b[0] * rb * h0.x, b[1] * rb * h0.y); wb[q].y = pk2(b[2] * rb * h0.z, b[3] * rb * h0.w); wb[q].z = pk2(b[4] * rb * h1.x, b[5] * rb * h1.y); wb[q].w = pk2(b[6] * rb * h1.z, b[7] * rb * h1.w); }
        u32x4* m0 = (u32x4*)(qrow + 1024) + 2 * lane; u32x4* m1 = (u32x4*)(qrow + 2048) + 2 * lane;
        m0[0] = wa[0]; m0[1] = wa[1]; m1[0] = wb[0]; m1[1] = wb[1];
    }
}

struct EpiBf16Scale {
    static constexpr bool PERM = true, AFTER_DRAIN = false;
    bf16_t* O; int ldc; const u64* rowss;
    struct State { u64 v[2][4]; };
    __device__ __forceinline__ void prefetch(const pg8::Unit& u, int wr, int wc, int fr, int fq, State& s) const {
        const int row0 = u.pm * 256 + wr * 64 + fr;
#pragma unroll
        for (int ai = 0; ai < 2; ++ai)
#pragma unroll
            for (int m = 0; m < 4; ++m) s.v[ai][m] = *(const __attribute__((address_space(1))) u64*)(rowss + row0 + ai * 128 + m * 16);
    }
    __device__ __forceinline__ void operator()(const f32x4 (&acc)[2][2][4][2], const pg8::Unit& u, int wr, int wc, int fr, int fq, const State& s) const {
        const int row0 = u.pm * 256 + wr * 64 + fr, col0 = u.pn * 256 + wc * 32 + 8 * fq;
#pragma unroll
        for (int ai = 0; ai < 2; ++ai)
#pragma unroll
            for (int m = 0; m < 4; ++m) { const int row = row0 + ai * 128 + m * 16; bf16_t* rowp = O + (size_t)row * ldc + col0;
                const float rs = rs_rstd(s.v[ai][m]);
#pragma unroll
                for (int bj = 0; bj < 2; ++bj) { const f32x4 v0 = acc[ai][bj][m][0] * rs, v1 = acc[ai][bj][m][1] * rs;
                    u32x4 w; w.x = pk2(v0[0], v0[1]); w.y = pk2(v0[2], v0[3]); w.z = pk2(v1[0], v1[1]); w.w = pk2(v1[2], v1[3]);
                    *(u32x4*)(rowp + bj * 128) = w; } }
    }
};
template <bool BASE_BF16> struct EpiResid {
    static constexpr bool PERM = true, AFTER_DRAIN = false;
    const float* base; const bf16_t* bsrc; float* out; bf16_t* xb; u64* rowss;
    struct State { u32x4 bb[2][2]; };
    __device__ __forceinline__ void prefetch(const pg8::Unit& u, int wr, int wc, int fr, int fq, State& s) const {
        const int row0 = u.pm * 256 + wr * 64 + fr, col0 = u.pn * 256 + wc * 32 + 8 * fq;
#pragma unroll
        for (int mm = 0; mm < 2; ++mm) { const size_t off = (size_t)(row0 + mm * 16) * DM + col0;
#pragma unroll
            for (int bj = 0; bj < 2; ++bj) { if (BASE_BF16) s.bb[mm][bj] = *(const __attribute__((address_space(1))) u32x4*)(bsrc + off + bj * 128); } }
    }
    __device__ __forceinline__ void operator()(const f32x4 (&acc)[2][2][4][2], const pg8::Unit& u, int wr, int wc, int fr, int fq, const State& s) const {
        const int row0 = u.pm * 256 + wr * 64 + fr, col0 = u.pn * 256 + wc * 32 + 8 * fq;
        f32x4 b[2][2][2][2];
        u32x4 bb[2][2][2];
#define EPI_LOADG(g, d, dd) do { _Pragma("unroll") for (int mm = 0; mm < 2; ++mm) { const size_t off = (size_t)(row0 + ((g) >> 1) * 128 + (((g) & 1) * 2 + mm) * 16) * DM + col0; \
        _Pragma("unroll") for (int bj = 0; bj < 2; ++bj) { if (BASE_BF16) dd[mm][bj] = *(const u32x4*)(bsrc + off + bj * 128); \
            else { d[mm][bj][0] = *(const f32x4*)(base + off + bj * 128); d[mm][bj][1] = *(const f32x4*)(base + off + bj * 128 + 4); } } } } while (0)
        if (BASE_BF16) {
#pragma unroll
            for (int mm = 0; mm < 2; ++mm)
#pragma unroll
                for (int bj = 0; bj < 2; ++bj) bb[0][mm][bj] = s.bb[mm][bj]; }
        else EPI_LOADG(0, b[0], bb[0]);
#pragma unroll
        for (int g = 0; g < 4; ++g) {
            if (g + 1 < 4) EPI_LOADG(g + 1, b[(g + 1) & 1], bb[(g + 1) & 1]);
            asm volatile("" ::: "memory");
#pragma unroll
            for (int mm = 0; mm < 2; ++mm) { const int ai = g >> 1, m = (g & 1) * 2 + mm, row = row0 + ai * 128 + m * 16; const size_t off = (size_t)row * DM + col0; float ss = 0.f;
#pragma unroll
                for (int bj = 0; bj < 2; ++bj) { f32x4 r0, r1;
                    if (BASE_BF16) { const u32x4 q = bb[g & 1][mm][bj]; r0 = (f32x4){bf_lo(q.x), bf_hi(q.x), bf_lo(q.y), bf_hi(q.y)}; r1 = (f32x4){bf_lo(q.z), bf_hi(q.z), bf_lo(q.w), bf_hi(q.w)}; }
                    else { r0 = b[g & 1][mm][bj][0]; r1 = b[g & 1][mm][bj][1]; }
                    const f32x4 v0 = r0 + acc[ai][bj][m][0], v1 = r1 + acc[ai][bj][m][1];
                    if (out) { *(f32x4*)(out + off + bj * 128) = v0; *(f32x4*)(out + off + bj * 128 + 4) = v1; }
                    u32x4 w; w.x = pk2(v0[0], v0[1]); w.y = pk2(v0[2], v0[3]); w.z = pk2(v1[0], v1[1]); w.w = pk2(v1[2], v1[3]); *(u32x4*)(xb + off + bj * 128) = w;
                    ss += ((v0[0] * v0[0] + v0[1] * v0[1]) + (v0[2] * v0[2] + v0[3] * v0[3])) + ((v1[0] * v1[0] + v1[1] * v1[1]) + (v1[2] * v1[2] + v1[3] * v1[3])); }
                ss += __shfl_xor(ss, 16); ss += __shfl_xor(ss, 32);
                if (fq == 0) (void)__hip_atomic_fetch_add(rowss + row, (u64)(ss * RS_FIX), __ATOMIC_RELAXED, __HIP_MEMORY_SCOPE_AGENT); }
            asm volatile("" ::: "memory");
        }
#undef EPI_LOADG
    }
};
__device__ __forceinline__ float silu_mul(float g, float u) { return g * u * __builtin_amdgcn_rcpf(1.0f + __builtin_amdgcn_exp2f(-1.4426950408889634f * g)); }
struct EpiSwiGLU {
    static constexpr bool PERM = true, AFTER_DRAIN = false;
    bf16_t* O; const u64* rowss;
    struct State { u64 v[2][4]; };
    __device__ __forceinline__ void prefetch(const pg8::Unit& u, int wr, int wc, int fr, int fq, State& s) const {
        const int row0 = u.pm * 256 + wr * 64 + fr;
#pragma unroll
        for (int ai = 0; ai < 2; ++ai)
#pragma unroll
            for (int m = 0; m < 4; ++m) s.v[ai][m] = *(const __attribute__((address_space(1))) u64*)(rowss + row0 + ai * 128 + m * 16);
    }
    __device__ __forceinline__ void operator()(const f32x4 (&acc)[2][2][4][2], const pg8::Unit& u, int wr, int wc, int fr, int fq, const State& s) const {
        const int row0 = u.pm * 256 + wr * 64 + fr, col0 = u.pn * 128 + wc * 32 + 8 * fq;
#pragma unroll
        for (int ai = 0; ai < 2; ++ai)
#pragma unroll
            for (int m = 0; m < 4; ++m) { const int row = row0 + ai * 128 + m * 16; bf16_t* rowp = O + (size_t)row * DFF + col0;
                const float rs = rs_rstd(s.v[ai][m]);
                const f32x4 g0 = acc[ai][0][m][0] * rs, g1 = acc[ai][0][m][1] * rs, u0 = acc[ai][1][m][0] * rs, u1 = acc[ai][1][m][1] * rs;
                u32x4 w; w.x = pk2(silu_mul(g0[0], u0[0]), silu_mul(g0[1], u0[1])); w.y = pk2(silu_mul(g0[2], u0[2]), silu_mul(g0[3], u0[3]));
                w.z = pk2(silu_mul(g1[0], u1[0]), silu_mul(g1[1], u1[1])); w.w = pk2(silu_mul(g1[2], u1[2]), silu_mul(g1[3], u1[3]));
                *(u32x4*)rowp = w; }
    }
};
#define KSWZ(row, colB) ((row) * 256 + ((colB) ^ (((row) & 7) << 4)))
#define SBAR() __builtin_amdgcn_sched_barrier(0)
__device__ __forceinline__ int crow(int r, int hi) { return (r & 3) + 8 * (r >> 2) + 4 * hi; }
__device__ __forceinline__ void qkt(f32x16& p0, f32x16& p1, const char* Ks, const bf16x8* qr, int r32, int hi) {
    p0 = f32x16{}; p1 = f32x16{};
#pragma unroll
    for (int d0 = 0; d0 < 8; ++d0) { const int cb = (d0 * 16 + hi * 8) * 2;
        const bf16x8 b0 = *reinterpret_cast<const bf16x8*>(Ks + KSWZ(r32, cb));
        const bf16x8 b1 = *reinterpret_cast<const bf16x8*>(Ks + KSWZ(32 + r32, cb));
        p0 = __builtin_amdgcn_mfma_f32_32x32x16_bf16(b0, qr[d0], p0, 0, 0, 0);
        p1 = __builtin_amdgcn_mfma_f32_32x32x16_bf16(b1, qr[d0], p1, 0, 0, 0); }
}
__device__ __forceinline__ int v_st(int k, int c) { const int kk = (k & ~0xC) | ((k & 4) << 1) | ((k & 8) >> 1); return ((kk >> 3) * 4 + (c >> 5)) * 512 + ((kk & 7) * 32 + (c & 31)) * 2; }
__device__ __forceinline__ int v_rd_base(int lane) { return ((lane & 3) << 3) | (((lane >> 2) & 3) << 6) | (((lane >> 4) & 1) << 5) | (((lane >> 5) & 1) << 8); }
constexpr int v_rd_off(int d0, int ks, int half) { return d0 * 512 + ks * 4096 + half * 2048; }
template <int OFF> __device__ __forceinline__ s16x4 tr_read(int vb) {
    s16x4 r; asm volatile("ds_read_b64_tr_b16 %0, %1 offset:%2" : "=&v"(r) : "v"(vb), "i"(OFF) : "memory"); return r;
}
template <int D0> __device__ __forceinline__ void pv_one(f32x16& od, int vb, bf16x8 pa0, bf16x8 pa1, bf16x8 pa2, bf16x8 pa3) {
    const s16x4 l0 = tr_read<v_rd_off(D0, 0, 0)>(vb), h0 = tr_read<v_rd_off(D0, 0, 1)>(vb), l1 = tr_read<v_rd_off(D0, 1, 0)>(vb), h1 = tr_read<v_rd_off(D0, 1, 1)>(vb);
    const s16x4 l2 = tr_read<v_rd_off(D0, 2, 0)>(vb), h2 = tr_read<v_rd_off(D0, 2, 1)>(vb), l3 = tr_read<v_rd_off(D0, 3, 0)>(vb), h3 = tr_read<v_rd_off(D0, 3, 1)>(vb);
    asm volatile("s_waitcnt lgkmcnt(0)" ::: "memory"); SBAR();
#define PK(L, H) (bf16x8){L[0], L[1], L[2], L[3], H[0], H[1], H[2], H[3]}
    od = __builtin_amdgcn_mfma_f32_32x32x16_bf16(pa0, PK(l0, h0), od, 0, 0, 0);
    od = __builtin_amdgcn_mfma_f32_32x32x16_bf16(pa1, PK(l1, h1), od, 0, 0, 0);
    od = __builtin_amdgcn_mfma_f32_32x32x16_bf16(pa2, PK(l2, h2), od, 0, 0, 0);
    od = __builtin_amdgcn_mfma_f32_32x32x16_bf16(pa3, PK(l3, h3), od, 0, 0, 0);
#undef PK
}
__device__ __forceinline__ int t5_bucket(int rel) {
    const int n = rel < 0 ? -rel : rel;
    int b = n;
    if (n >= 8) { b = 5 + (31 - __builtin_clz(n)); if (b > 15) b = 15; }
    return b + (rel > 0 ? 16 : 0);
}

#define GAS __attribute__((address_space(1)))
__device__ __forceinline__ bf16_t* dil_buf(const Params& p, int c, int dsel, int layer) {
    const size_t ct0 = (size_t)chunk_t0(c), cm = (size_t)chunk_m(c);
    unsigned char* dsl = (unsigned char*)p.out + ct0 * 8192;
    if (dsel == 2) return (bf16_t*)(dsl + cm * 4096);
    if (layer == 0) return (bf16_t*)(dsel == 0 ? dsl : dsl + cm * 6144);
    return (bf16_t*)(p.ws + OFF_H + ct0 * 4096 + (size_t)dsel * cm * 2048);
}
template <bool NA>
__device__ __forceinline__ void attn_item(const Params& p, int layer, int dsel, int item, char* lds) {
    const int tid = ltid(), wid = __builtin_amdgcn_readfirstlane(tid >> 6), lane = tid & 63, r32 = lane & 31, hi = lane >> 5;
    bf16_t* qkv = (bf16_t*)(p.ws + OFF_QKV);
    float* wsf = (float*)(lds + 131072 + 256) + wid * 64; float* li_l = wsf; float* al_l = wsf + 32;
    float* T = (float*)(lds + 131072 + 256 + 2048);
    const float NINF = -__builtin_inff();
    const int h = item & 7, gb = item >> 3;
    int base, L, lb;
    if (gb < 64) { base = 0; L = LP; lb = gb; } else { const int s = (gb - 64) >> 4; lb = (gb - 64) & 15; base = LP + s * LS; L = LS; }
    const int dshift = NA ? 0 : 2 * dsel, d = 1 << dshift;
    const int nbr = (L >> 8) >> dshift;
    const int res = NA ? 0 : lb / nbr, b = NA ? lb : lb % nbr;
    const int q0 = b * 256, Lsub = L >> dshift;
    const int colq = (NA ? 0 : 3072) + h * 128, colk = colq + 1024, colv = colq + 2048;
    const int tok0 = base + res;
    int tlo, thi, kr0 = 0, rq = 0, off = wid >> 1;
    if (NA) { const int rows = L >> 6, r0 = 4 * lb; kr0 = min(max(r0 - 4, 0), rows - 8); const int kr3 = min(max(r0 + 3 - 4, 0), rows - 8); tlo = 0; thi = kr3 + 8 - kr0;
        rq = r0 + (wid >> 1); off = min(max(rq - 4, 0), rows - 8) - kr0; }
    else { tlo = (q0 == 0) ? 1 : 0; thi = (q0 + 256 == Lsub) ? 5 : 6; }
    const int S = NA ? 8 : 3;
    const int sr = tid >> 4, sc = (tid & 15) * 8, vst0 = v_st(sr, sc), vst1 = v_st(32 + sr, sc), kst0 = KSWZ(sr, sc * 2), kst1 = KSWZ(32 + sr, sc * 2);
#define KT(t) (NA ? (kr0 + (t)) * 64 : q0 - 64 + 64 * (t))
#define SLOAD(t, R) do { const bf16_t* r0p = qkv + (size_t)(tok0 + (KT(t) + sr) * d) * NQKV + sc; const bf16_t* r1p = r0p + (size_t)32 * d * NQKV; \
    R[0] = *(const GAS bf16x8*)(r0p + colk); R[1] = *(const GAS bf16x8*)(r1p + colk); R[2] = *(const GAS bf16x8*)(r0p + colv); R[3] = *(const GAS bf16x8*)(r1p + colv); } while (0)
#define SWRITE(bi, R) do { char* bb = lds + (bi) * 32768; *(bf16x8*)(bb + vst0) = R[2]; *(bf16x8*)(bb + vst1) = R[3]; *(bf16x8*)(bb + 16384 + kst0) = R[0]; *(bf16x8*)(bb + 16384 + kst1) = R[1]; } while (0)
    bf16x8 st[4][4];
#pragma unroll
    for (int i = 0; i < 4; ++i) if (i >= tlo && i < thi) SLOAD(i, st[i]);
    bf16x8 qr[8];
    { const bf16_t* Qw = qkv + (size_t)(tok0 + (q0 + wid * 32 + r32) * d) * NQKV + colq + hi * 8;
#pragma unroll
      for (int d0 = 0; d0 < 8; ++d0) qr[d0] = *(const GAS bf16x8*)(Qw + d0 * 16); }
    float tv0 = 0.f, tv1 = 0.f;
    if (NA) { const int i0 = tid - 48, i1 = tid + 512 - 48; if (i0 >= 0 && i0 < 465) tv0 = p.rpb[((size_t)layer * 465 + i0) * 8 + h] * (1.0f / SCALE); if (tid < 64 && i1 < 465) tv1 = p.rpb[((size_t)layer * 465 + i1) * 8 + h] * (1.0f / SCALE); }
    else { const int j = tid - 128; tv0 = (tid < 256 && j >= -64 && j <= 64) ? p.t5[t5_bucket(d * j) * 8 + h] * (1.0f / SCALE) : NINF; }
    __syncthreads();
    if (NA) { T[tid] = tv0; if (tid < 64) T[tid + 512] = tv1; } else { if (tid < 256) T[tid] = tv0; }
#pragma unroll
    for (int i = 0; i < 4; ++i) if (i >= tlo && i < thi) SWRITE(i, st[i]);
    const int cq = 32 * (wid & 1) + r32, clo = min(max(cq - 8, 0), 48);
    unsigned vmask = 0;
    if (NA) {
#pragma unroll
        for (int r = 0; r < 16; ++r) { const int ck = crow(r, hi); if ((unsigned)(ck - clo) < 16u) vmask |= 1u << r; if ((unsigned)(ck + 32 - clo) < 16u) vmask |= 1u << (16 + r); } }
    const int vrb = (int)(uintptr_t)lds + v_rd_base(lane);
    float m_reg = -1e30f, l_reg = 0.f; f32x16 o[4] = {};
    constexpr float C = SCALE * 1.4426950408889634f;
    for (int s = 0; s < S; ++s) {
        __syncthreads();
        const bool ld = (s + 1 < S) && (s + 4 < thi);
        if (ld) SLOAD(s + 4, st[0]);
        const int t = off + s;
        if (t >= tlo && t < thi) {
            const char* Kb = lds + (t & 3) * 32768 + 16384; const int vb0 = vrb + (t & 3) * 32768;
            f32x16 p0, p1;
            qkt(p0, p1, Kb, qr, r32, hi);
            if (NA) { const float* Tb = T + 48 + (kr0 + t - rq + 7) * 31 + 15 - cq + 4 * hi;
#pragma unroll
                for (int r = 0; r < 16; ++r) { const int oo = (r & 3) + 8 * (r >> 2); const float b0 = Tb[oo], b1 = Tb[oo + 32];
                    p0[r] = ((vmask >> r) & 1u) ? p0[r] + b0 : NINF; p1[r] = ((vmask >> (16 + r)) & 1u) ? p1[r] + b1 : NINF; } }
            else { const float* Tb = T + (KT(t) - (q0 + 32 * wid) - r32 + 128 + 4 * hi);
#pragma unroll
                for (int r = 0; r < 16; ++r) { const int oo = (r & 3) + 8 * (r >> 2); p0[r] += Tb[oo]; p1[r] += Tb[oo + 32]; } }
            float pmax = p0[0];
#pragma unroll
            for (int r = 1; r < 16; ++r) pmax = fmaxf(pmax, p0[r]);
#pragma unroll
            for (int r = 0; r < 16; ++r) pmax = fmaxf(pmax, p1[r]);
            { auto rr = __builtin_amdgcn_permlane32_swap(__float_as_uint(pmax), __float_as_uint(pmax), false, false);
              pmax = fmaxf(__uint_as_float(rr[0]), __uint_as_float(rr[1])); }
            float mn = m_reg, alpha = 1.f;
            if (!__all(pmax - m_reg <= 8.0f / SCALE)) { mn = fmaxf(m_reg, pmax); alpha = __builtin_amdgcn_exp2f((m_reg - mn) * C); m_reg = mn; }
            const float mnC = -mn * C;
            float ps = 0.f;
#pragma unroll
            for (int r = 0; r < 16; ++r) { p0[r] = __builtin_amdgcn_exp2f(fmaf(p0[r], C, mnC)); p1[r] = __builtin_amdgcn_exp2f(fmaf(p1[r], C, mnC)); ps += p0[r] + p1[r]; }
            { auto rr = __builtin_amdgcn_permlane32_swap(__float_as_uint(ps), __float_as_uint(ps), false, false);
              ps = __uint_as_float(rr[0]) + __uint_as_float(rr[1]); }
            l_reg = l_reg * alpha + ps;
            bf16x8 pa0, pa1, pa2, pa3;
#define PK4(P, BASE, OUT) do { unsigned a0 = pk2(P[BASE + 0], P[BASE + 1]), a1 = pk2(P[BASE + 2], P[BASE + 3]);   \
    unsigned b0 = pk2(P[BASE + 4], P[BASE + 5]), b1 = pk2(P[BASE + 6], P[BASE + 7]);                              \
    auto r0 = __builtin_amdgcn_permlane32_swap(a0, b0, false, false); auto r1 = __builtin_amdgcn_permlane32_swap(a1, b1, false, false); \
    u32x4 w = {r0[0], r1[0], r0[1], r1[1]}; OUT = *reinterpret_cast<bf16x8*>(&w); } while (0)
            PK4(p0, 0, pa0); PK4(p0, 8, pa1); PK4(p1, 0, pa2); PK4(p1, 8, pa3);
#undef PK4
            if (__any(alpha < 1.f)) { if (hi == 0) al_l[r32] = alpha; asm volatile("s_waitcnt lgkmcnt(0)" ::: "memory");
#pragma unroll
                for (int r = 0; r < 16; ++r) { const float a = al_l[crow(r, hi)];
#pragma unroll
                    for (int dd = 0; dd < 4; ++dd) o[dd][r] *= a; } }
            pv_one<0>(o[0], vb0, pa0, pa1, pa2, pa3); pv_one<1>(o[1], vb0, pa0, pa1, pa2, pa3); pv_one<2>(o[2], vb0, pa0, pa1, pa2, pa3); pv_one<3>(o[3], vb0, pa0, pa1, pa2, pa3);
        }
        if (ld) { __syncthreads();
            SWRITE(s & 3, st[0]); }
    }
#undef SLOAD
#undef SWRITE
#undef KT
    if (hi == 0) li_l[r32] = l_reg; asm volatile("s_waitcnt lgkmcnt(0)" ::: "memory");
    bf16_t* Ob; int ldo;
    if (NA) { Ob = qkv + colq; ldo = NQKV; }
    else { const int c = chunk_of(base); Ob = dil_buf(p, c, dsel, layer) - (size_t)chunk_t0(c) * 1024 + h * 128; ldo = 1024; }
    if (!NA && hi == 0) { float* lse = (float*)(p.ws + OFF_LSE) + (size_t)dsel * NTOK * 8; lse[(size_t)(tok0 + (q0 + wid * 32 + r32) * d) * 8 + h] = m_reg * SCALE + __logf(l_reg); }
#pragma unroll
    for (int r = 0; r < 16; ++r) { const int orow = crow(r, hi); const float rl = __builtin_amdgcn_rcpf(li_l[orow]);
        bf16_t* op = Ob + (size_t)(tok0 + (q0 + wid * 32 + orow) * d) * ldo + r32;
#pragma unroll
        for (int dd = 0; dd < 4; ++dd) { const unsigned w = pk2(o[dd][r] * rl, 0.f); op[dd * 32] = (bf16_t)(w & 0xffffu); } }
}
template <class Epi>
__device__ __forceinline__ void run_gemm(char* lds, int M, const bf16_t* A, int lda, const bf16_t* Bt, int N, int K, const Epi& E) {
    pg8::Gemm g; g.A = A; g.Bt = Bt; g.M = M; g.N = N; g.K = K; g.lda = lda;
    pg8::StaticOrder S; S.init(M, N, lgdim(), lbid());
    pg8::gemm_phase<Epi, pg8::StaticOrder, false>((PG8_LAS unsigned char*)lds, g, S, E, nullptr);
}

template <class T> __device__ __forceinline__ T* launder(T* x) { asm volatile("" : "+s"(x)); return x; }
__device__ __forceinline__ void run_phase(const Params& p0, int layer, int ph, int chunk, char* shm) {
    Params p = p0;
    p.ws = launder(p.ws); p.out = launder(p.out);
    const int tid = ltid(), wid = __builtin_amdgcn_readfirstlane(tid >> 6), lane = tid & 63;
    const int G = lgdim(), bid = lbid(), gw = bid * 8 + wid, ngw = G * 8;
    const int t0 = chunk_t0(chunk), CM = chunk_m(chunk), nit = CM / 256 * 8, it0 = t0 / 256 * 8;
    bf16_t* qkv = (bf16_t*)(p.ws + OFF_QKV) + (size_t)t0 * NQKV; bf16_t* Hb = (bf16_t*)(p.ws + OFF_H) + (size_t)t0 * DM; unsigned char* wl = p.ws + (size_t)layer * WT_LAYER;
    u64* rsa = (u64*)(p.ws + OFF_RSA) + t0; u64* rsf = (u64*)(p.ws + OFF_RSF) + t0;
    bf16_t* xs2 = (bf16_t*)(p.out + (size_t)t0 * DM);
    switch (ph) {
    case 0: phase_weights(p, 0, shm, gw, ngw, wid, lane); phase_weights(p, 1, shm, gw, ngw, wid, lane); phase_cvt(p, gw, ngw, lane); break;
    case 1: { EpiBf16Scale E; E.O = qkv; E.ldc = NQKV; E.rowss = rsa; run_gemm(shm, CM, layer ? xs2 : Hb, DM, (bf16_t*)(wl + OFF_WIN), NQKV, DM, E); } break;
    case 2: for (int it = bid; it < 4 * nit; it += G) { if (it < nit) attn_item<true>(p, layer, 0, it0 + it, shm); else attn_item<false>(p, layer, (it - nit) / nit, it0 + (it - nit) % nit, shm); } break;
    case 6: phase_mixnorm(p, layer, t0, t0 + CM, gw, ngw, lane); break;
    case 7: { EpiResid<true> E; E.base = nullptr; E.bsrc = layer ? xs2 : Hb; E.out = nullptr; E.xb = Hb; E.rowss = rsf; run_gemm(shm, CM, qkv + 1024, NQKV, (bf16_t*)(wl + OFF_WOUT), DM, DM, E); } break;
    case 9: { EpiSwiGLU E; E.O = (bf16_t*)(p.ws + OFF_QKV) + (size_t)t0 * DFF; E.rowss = rsf; run_gemm(shm, CM, Hb, DM, (bf16_t*)(wl + OFF_WGU), 2 * DFF, DM, E); } break;
    case 10: { EpiResid<true> E; E.base = nullptr; E.bsrc = Hb; E.out = nullptr; E.xb = layer + 1 < DEPTH ? xs2 : Hb; E.rowss = rsa; run_gemm(shm, CM, (bf16_t*)(p.ws + OFF_QKV) + (size_t)t0 * DFF, DFF, (bf16_t*)(wl + OFF_WDN), DM, DFF, E); } break;
    default: phase_final(p, t0, t0 + CM, gw, ngw, lane); break;
    }
}
__global__ void __launch_bounds__(512) fwd_megakernel(Params p) {
    extern __shared__ __attribute__((aligned(16))) char shm[];
    cg::grid_group grid = cg::this_grid();
    volatile XLAS unsigned* st = (volatile XLAS unsigned*)(shm + pg8::STAGE_BYTES);
    if (threadIdx.x == 0) { st[0] = 0u; st[1] = 0u; st[2] = blockIdx.x; st[3] = 0u; }
    __syncthreads();
    const XcdBarrier xb = xcd_barrier_post((unsigned*)(p.ws + OFF_BAR), st);
    constexpr int PER_CHUNK = 6 * DEPTH + 1, NSTEP = 1 + NCHUNK * PER_CHUNK;
    for (int step = 0; step < NSTEP; ++step) {
        int layer = 0, ph = 0, chunk = 0;
        if (step > 0) { chunk = (step - 1) / PER_CHUNK; const int sc = (step - 1) % PER_CHUNK;
            if (sc == PER_CHUNK - 1) ph = 11; else { layer = sc / 6; const int s6 = sc % 6; ph = s6 < 2 ? s6 + 1 : (s6 == 2 ? 6 : (s6 == 3 ? 7 : s6 + 5)); } }
        run_phase(p, layer, ph, chunk, shm);
        if (step == 0) { grid.sync();
            if (threadIdx.x == 0) { unsigned* bar = (unsigned*)(p.ws + OFF_BAR); bool ok = (gridDim.x & 7u) == 0u;
                for (unsigned j = 0; j < 8; ++j) ok = ok && (xb_ld(&bar[XB_XCNT(j)]) == gridDim.x / 8u);
                if (ok) st[2] = st[3] * 8u + xb.x; }
            __syncthreads(); }
        else if (step + 1 < NSTEP) xcd_barrier(xb);
    }
}

extern "C" void kernel_launch(void* const* d_in, const int* in_sizes, int n_in, void* d_out, int out_size, void* d_ws, size_t ws_size, hipStream_t stream) {
    static int grid = 0;
    if (grid == 0) {
        if (n_in != 14 || ws_size < WS_END) { fprintf(stderr, "kernel_launch: need 14 inputs and %zu bytes of workspace, got %d / %zu\n", (size_t)WS_END, n_in, ws_size); grid = -1; return; }
        int dev = 0, cus = 0, per_cu = 0;
        if (hipGetDevice(&dev) != hipSuccess || hipDeviceGetAttribute(&cus, hipDeviceAttributeMultiprocessorCount, dev) != hipSuccess) { grid = -1; return; }
        if (hipFuncSetAttribute((const void*)fwd_megakernel, hipFuncAttributeMaxDynamicSharedMemorySize, LDS_BYTES) != hipSuccess) { fprintf(stderr, "kernel_launch: hipFuncSetAttribute failed\n"); grid = -1; return; }
        if (hipOccupancyMaxActiveBlocksPerMultiprocessor(&per_cu, (const void*)fwd_megakernel, 512, LDS_BYTES) != hipSuccess || per_cu < 1) { fprintf(stderr, "kernel_launch: occupancy query gave %d\n", per_cu); per_cu = 1; }
        (void)hipGetLastError();
        grid = cus;
    }
    if (grid < 0) return;
    Params p{};
    p.xp = (const float*)d_in[0]; p.xs = (const float*)d_in[1]; p.w_in = (const float*)d_in[2]; p.w_out = (const float*)d_in[3]; p.g_attn = (const float*)d_in[4];
    p.g_na = (const float*)d_in[5]; p.g_dil = (const float*)d_in[6]; p.rpb = (const float*)d_in[7]; p.t5 = (const float*)d_in[8]; p.g_ffn = (const float*)d_in[9];
    p.w_gate = (const float*)d_in[10]; p.w_up = (const float*)d_in[11]; p.w_down = (const float*)d_in[12]; p.g_final = (const float*)d_in[13];
    p.out = (float*)d_out; p.ws = (unsigned char*)d_ws;
    if (hipMemsetAsync((char*)d_ws + OFF_BAR, 0, 16384, stream) != hipSuccess) { fprintf(stderr, "kernel_launch: memset failed\n"); return; }
    void* args[] = {&p};
    hipError_t e = hipLaunchCooperativeKernel((const void*)fwd_megakernel, dim3(grid), dim3(512), args, LDS_BYTES, stream);
    if (e != hipSuccess) fprintf(stderr, "kernel_launch: cooperative launch failed: %s (grid %d)\n", hipGetErrorString(e), grid);
}
```
